# Optimizing an MI355X kernel written in HIP

```python
import jax, jax.numpy as jnp
from jax import lax
import numpy as np

D_MODEL = 1024
BATCH = 16
SEQ = 256
DEPTH = 1
DEC_BATCH = 2
DEC_SEQ = 4096
PAST_LEN = 512

GRID_W = 64
HEAD_DIM = 64
D_A = D_MODEL
N_HEADS_A = D_A // HEAD_DIM
D_B = D_MODEL // 2
POOL_WINDOWS = (2, 4, 8, 16)
POOL_GROUPS = 4
POOL_GROUP_DIM = D_B // POOL_GROUPS
LORA_W = 64
LORA_A = 64
LORA_G = 128
D_FF = 2816
N_MOD = 9
SHIFT_W = 3 * D_A + 2 * LORA_W + 2 * LORA_A + LORA_G
MIX_IN = SHIFT_W + D_B + 2 * D_MODEL
ALPHA = (2 * DEPTH) ** 0.25
BETA = (8 * DEPTH) ** -0.25
LN_EPS = 1e-5
GN_EPS = 64e-5

kernel_name = 'hybrid_rwkv7_pool_diffusion_step'


def _layer_norm(x, g, b):
    xf = x.astype(jnp.float32)
    mu = jnp.mean(xf, -1, keepdims=True)
    var = jnp.mean(jnp.square(xf - mu), -1, keepdims=True)
    return ((xf - mu) * lax.rsqrt(var + LN_EPS) * g + b).astype(x.dtype)


def _swiglu(h, w_in, w_out):
    gate, up = jnp.split(h @ w_in, 2, axis=-1)
    return (jax.nn.silu(gate) * up) @ w_out


def _modulation(cvec, w_mod, b_mod):
    m = jax.nn.silu(cvec) @ w_mod + b_mod
    return m.reshape(cvec.shape[0], 1, N_MOD, D_MODEL)


def _shift_seq(p):
    b, t, c = p.shape
    q = p.reshape(b, t, c // 2, 2)
    prev = jnp.pad(q[:, :-1, :, 0], ((0, 0), (1, 0), (0, 0)))
    nxt = jnp.pad(q[:, 1:, :, 1], ((0, 0), (0, 1), (0, 0)))
    return jnp.stack([prev, nxt], axis=-1).reshape(b, t, c)


def _shift_grid(p):
    b, t, c = p.shape
    rows = t // GRID_W
    q = p.reshape(b, rows, GRID_W, c // 4, 4)
    left = jnp.pad(q[:, :, :-1, :, 0], ((0, 0), (0, 0), (1, 0), (0, 0)))
    right = jnp.pad(q[:, :, 1:, :, 1], ((0, 0), (0, 0), (0, 1), (0, 0)))
    up = jnp.pad(q[:, :-1, :, :, 2], ((0, 0), (1, 0), (0, 0), (0, 0)))
    down = jnp.pad(q[:, 1:, :, :, 3], ((0, 0), (0, 1), (0, 0), (0, 0)))
    return jnp.stack([left, right, up, down], axis=-1).reshape(b, t, c)


def _centred_pool_residual(p):
    b, t, c = p.shape
    pf = p.astype(jnp.float32)
    pos = jnp.arange(t)
    outs = []
    for gi, w in enumerate(POOL_WINDOWS):
        pg = pf[..., gi * POOL_GROUP_DIM:(gi + 1) * POOL_GROUP_DIM]
        cs = jnp.concatenate([jnp.zeros((b, 1, POOL_GROUP_DIM), jnp.float32), jnp.cumsum(pg, axis=1)], axis=1)
        lo = jnp.clip(pos - w // 2, 0, t)
        hi = jnp.clip(pos + w - w // 2, 0, t)
        mean = (cs[:, hi] - cs[:, lo]) / (hi - lo).astype(jnp.float32)[:, None]
        outs.append(mean - pg)
    return jnp.concatenate(outs, axis=-1).astype(p.dtype)


def _heads(z):
    return z.reshape(z.shape[:-1] + (N_HEADS_A, HEAD_DIM))


def _to_scan(z):
    z = jnp.concatenate([z[:1], jnp.flip(z[1:], axis=2)], axis=0)
    return jnp.moveaxis(z, 2, 0)


def _from_scan(y):
    y = jnp.moveaxis(y, 0, 2)
    return y[0] + jnp.flip(y[1], axis=1)


def _rwkv7_step(S, inp):
    r, w, k, v, kk, a = inp
    sa = jnp.einsum('dbhvk,dbhk->dbhv', S, kk)
    S = S * w[..., None, :] - sa[..., :, None] * (kk * a)[..., None, :] + v[..., :, None] * k[..., None, :]
    return S, jnp.einsum('dbhvk,dbhk->dbhv', S, r)


def _token_mixer(h, s0, latent, p):
    f32 = jnp.float32
    proj = h @ p['w_mix_in']
    ps = proj[..., :SHIFT_W]
    pool_in = proj[..., SHIFT_W:SHIFT_W + D_B]
    gate_logits = proj[..., SHIFT_W + D_B:]
    shifted = _shift_grid(ps) if latent else _shift_seq(ps)
    ps = (ps + p['mu_shift'] * (shifted - ps)).astype(f32)
    b, t, _ = ps.shape
    o1, o2, o3 = D_A, 2 * D_A, 3 * D_A
    o4 = o3 + 2 * LORA_W
    o5 = o4 + 2 * LORA_A
    r, k, v = ps[..., :o1], ps[..., o1:o2], ps[..., o2:o3]
    w_down = ps[..., o3:o4].reshape(b, t, 2, LORA_W)
    a_down = ps[..., o4:o5].reshape(b, t, 2, LORA_A)
    g_down = ps[..., o5:]
    w_raw = p['w0'][:, None, None, :] + jnp.einsum('btdr,drc->dbtc', jnp.tanh(w_down), p['w_up'])
    decay = jnp.exp(-jnp.exp(-jax.nn.softplus(-w_raw) - 0.5))
    a = jax.nn.sigmoid(p['a0'][:, None, None, :] + jnp.einsum('btdr,drc->dbtc', a_down, p['a_up']))
    g = jax.nn.sigmoid(g_down) @ p['g_up']
    kk = _heads(k * p['k_k'])
    kk = kk / jnp.maximum(jnp.sqrt(jnp.sum(kk * kk, -1, keepdims=True)), 1e-12)
    k_dir = k[None] * (1.0 + (a - 1.0) * p['k_a'])
    r_h, k_h, v_h = _heads(r), _heads(k), _heads(v)
    both = lambda z: jnp.broadcast_to(z[None], (2,) + z.shape)
    xs = (_to_scan(both(r_h)), _to_scan(_heads(decay)), _to_scan(_heads(k_dir)),
          _to_scan(both(v_h)), _to_scan(both(kk)), _to_scan(_heads(a)))
    s_final, y = lax.scan(_rwkv7_step, s0.astype(f32), xs)
    y = _from_scan(y)
    mu = jnp.mean(y, -1, keepdims=True)
    var = jnp.mean(jnp.square(y - mu), -1, keepdims=True)
    y = ((y - mu) * lax.rsqrt(var + GN_EPS)).reshape(b, t, D_A) * p['lnx_g'] + p['lnx_b']
    bonus = jnp.sum(r_h * k_h * p['r_k'], -1, keepdims=True) * v_h
    y = (y + bonus.reshape(b, t, D_A)) * g
    y_a = y.astype(h.dtype) @ p['w_o_rwkv']
    u = _centred_pool_residual(pool_in).reshape(b, t, POOL_GROUPS, POOL_GROUP_DIM)
    u = jnp.einsum('btgc,gcd->btgd', u, p['w_pool']).reshape(b, t, D_B) * p['pool_scale']
    y_b = u @ p['w_o_pool']
    gate_a = jax.nn.sigmoid(gate_logits[..., :D_MODEL])
    gate_b = jax.nn.sigmoid(gate_logits[..., D_MODEL:])
    return (gate_a * y_a + gate_b * y_b) @ p['w_out'], s_final


def _trunk_layer(x, mod, s0, latent, p):
    m = [mod[:, :, i, :] for i in range(N_MOD)]
    h = x * (1.0 + m[1]) + m[0]
    x = _layer_norm(ALPHA * x + 0.5 * m[2] * _swiglu(h, p['ffn_in'][0], p['ffn_out'][0]), p['ln_g'][0], p['ln_b'][0])
    h = x * (1.0 + m[4]) + m[3]
    mix, s_final = _token_mixer(h, s0, latent, p)
    x = _layer_norm(ALPHA * x + m[5] * mix, p['ln_g'][1], p['ln_b'][1])
    h = x * (1.0 + m[7]) + m[6]
    x = _layer_norm(ALPHA * x + 0.5 * m[8] * _swiglu(h, p['ffn_in'][1], p['ffn_out'][1]), p['ln_g'][2], p['ln_b'][2])
    return x, s_final


def setup_inputs(seed: int = 0) -> dict:
    key = jax.random.key(seed)
    ks = jax.random.split(key, 32)
    f32 = jnp.float32
    nrm = lambda k, shape, scale: jax.random.normal(k, shape, f32) * scale
    return {
        'x_prompt': nrm(ks[0], (BATCH, SEQ, D_MODEL), 1.0),
        'x_sample': nrm(ks[1], (DEC_BATCH, DEC_SEQ, D_MODEL), 1.0),
        'c': nrm(ks[2], (DEC_BATCH, D_MODEL), 1.0),
        'state_rwkv': nrm(ks[3], (DEC_BATCH, DEPTH, 2, N_HEADS_A, HEAD_DIM, HEAD_DIM), 0.5),
        'c_ctx': nrm(ks[4], (D_MODEL,), 1.0),
        'w_mod': nrm(ks[5], (DEPTH, D_MODEL, N_MOD * D_MODEL), D_MODEL ** -0.5),
        'b_mod': nrm(ks[6], (DEPTH, N_MOD * D_MODEL), 0.01),
        'ln_g': 1.0 + nrm(ks[7], (DEPTH, 3, D_MODEL), 0.05),
        'ln_b': nrm(ks[8], (DEPTH, 3, D_MODEL), 0.02),
        'ffn_in': nrm(ks[9], (DEPTH, 2, D_MODEL, 2 * D_FF), D_MODEL ** -0.5),
        'ffn_out': nrm(ks[10], (DEPTH, 2, D_FF, D_MODEL), BETA * D_FF ** -0.5),
        'w_mix_in': nrm(ks[11], (DEPTH, D_MODEL, MIX_IN), D_MODEL ** -0.5),
        'mu_shift': jax.random.uniform(ks[12], (DEPTH, SHIFT_W), f32),
        'w0': nrm(ks[13], (DEPTH, 2, D_A), 0.5),
        'w_up': nrm(ks[14], (DEPTH, 2, LORA_W, D_A), LORA_W ** -0.5),
        'a0': nrm(ks[15], (DEPTH, 2, D_A), 0.5),
        'a_up': nrm(ks[16], (DEPTH, 2, LORA_A, D_A), LORA_A ** -0.5),
        'g_up': nrm(ks[17], (DEPTH, LORA_G, D_A), LORA_G ** -0.5),
        'k_k': 0.85 + nrm(ks[18], (DEPTH, D_A), 0.05),
        'k_a': 1.0 + nrm(ks[19], (DEPTH, D_A), 0.05),
        'r_k': nrm(ks[20], (DEPTH, N_HEADS_A, HEAD_DIM), 0.1),
        'lnx_g': 1.0 + nrm(ks[21], (DEPTH, D_A), 0.05),
        'lnx_b': nrm(ks[22], (DEPTH, D_A), 0.02),
        'w_o_rwkv': nrm(ks[23], (DEPTH, D_A, D_MODEL), BETA * D_A ** -0.5),
        'w_pool': nrm(ks[24], (DEPTH, POOL_GROUPS, POOL_GROUP_DIM, POOL_GROUP_DIM), POOL_GROUP_DIM ** -0.5),
        'pool_scale': 1.0 + nrm(ks[25], (DEPTH, D_B), 0.05),
        'w_o_pool': nrm(ks[26], (DEPTH, D_B, D_MODEL), BETA * D_B ** -0.5),
        'w_out': nrm(ks[27], (DEPTH, D_MODEL, D_MODEL), BETA * D_MODEL ** -0.5),
    }


def reference(x_prompt, x_sample, c, state_rwkv, c_ctx, w_mod, b_mod, ln_g, ln_b, ffn_in, ffn_out,
              w_mix_in, mu_shift, w0, w_up, a0, a_up, g_up, k_k, k_a, r_k, lnx_g, lnx_b,
              w_o_rwkv, w_pool, pool_scale, w_o_pool, w_out):
    y_p = x_prompt
    y_s = x_sample
    ctx_states = []
    for l in range(DEPTH):
        p = {
            'ln_g': ln_g[l], 'ln_b': ln_b[l], 'ffn_in': ffn_in[l], 'ffn_out': ffn_out[l],
            'w_mix_in': w_mix_in[l], 'mu_shift': mu_shift[l], 'w0': w0[l], 'w_up': w_up[l],
            'a0': a0[l], 'a_up': a_up[l], 'g_up': g_up[l], 'k_k': k_k[l], 'k_a': k_a[l],
            'r_k': r_k[l], 'lnx_g': lnx_g[l], 'lnx_b': lnx_b[l], 'w_o_rwkv': w_o_rwkv[l],
            'w_pool': w_pool[l], 'pool_scale': pool_scale[l], 'w_o_pool': w_o_pool[l], 'w_out': w_out[l],
        }
        mod_ctx = _modulation(c_ctx[None, :], w_mod[l], b_mod[l])
        s0_ctx = jnp.zeros((2, y_p.shape[0], N_HEADS_A, HEAD_DIM, HEAD_DIM), jnp.float32)
        y_p, s_ctx = _trunk_layer(y_p, mod_ctx, s0_ctx, False, p)
        ctx_states.append(jnp.moveaxis(s_ctx, 0, 1))
        mod_lat = _modulation(c, w_mod[l], b_mod[l])
        s0_lat = jnp.moveaxis(state_rwkv[:, l], 1, 0)
        y_s, _ = _trunk_layer(y_s, mod_lat, s0_lat, True, p)
    new_state_rwkv = jnp.stack(ctx_states, axis=1).astype(x_prompt.dtype)
    return (y_p, y_s, new_state_rwkv)
```

```cpp
#include <hip/hip_runtime.h>
#include <hip/hip_cooperative_groups.h>
#include <cstdio>
#include <cstdint>
namespace cg = cooperative_groups;
#ifndef MK_MULTI
#define MK_MULTI 0
#endif
namespace pg8 {
#define PG8_LAS __attribute__((address_space(3)))
typedef unsigned short bf16_t;
typedef _Float16 bf16x8 __attribute__((ext_vector_type(8)));
typedef float f32x4 __attribute__((ext_vector_type(4)));
typedef unsigned u32x4 __attribute__((ext_vector_type(4)));
constexpr int BM = 256, BK = 64, HALF = 128, HTB = HALF * BK * 2  , STAGE_BYTES = 8 * HTB, NXCD = 8, WGM = 8;

__host__ __device__ __forceinline__ int lds_byte(int r, int c) { const int st = (r >> 4) * 2 + (c >> 5), rr = r & 15, cc = c & 31, ob = rr * 64 + cc * 2; return st * 1024 + (ob ^ (((ob >> 9) & 1) << 5)); }
__host__ __device__ __forceinline__ void stage_rc(int b, int& R, int& C) { const int st = b / 1024, sb = b % 1024, swz = sb ^ (((sb >> 9) & 1) << 5); R = (st >> 1) * 16 + swz / 64; C = (st & 1) * 32 + (swz % 64) / 2; }
__host__ __device__ __forceinline__ int perm32(int rho) { const int n = rho >> 4, i = rho & 15; return 8 * (i >> 2) + 4 * n + (i & 3); }

struct Unit { int pm, pn; };
struct Gemm { const bf16_t* A; const bf16_t* Bt; int M, N, K; };

struct StaticOrder {
    int nM, nN, nwg, G, c;
    __host__ __device__ void init(int M, int N, int G_, int c_) { nM = M / BM; nN = N / BM; nwg = nM * nN; G = G_; c = c_; }
    __host__ __device__ bool next(int i, Unit& u) const {
        const long L = (long)i * G + c; if (L >= nwg) return false;
        int wgid = (int)L; { const int q = nwg / NXCD, r = nwg % NXCD, xcd = wgid % NXCD, off = wgid / NXCD; wgid = (xcd < r ? xcd * (q + 1) : r * (q + 1) + (xcd - r) * q) + off; }
        const int nig = WGM * nN, gid = wgid / nig, fm = gid * WGM, gsz = (nM - fm) < WGM ? (nM - fm) : WGM;
        u.pm = fm + ((wgid % nig) % gsz); u.pn = (wgid % nig) / gsz; return true;
    }
    __device__ __forceinline__ void a_ready(const Unit&) const {}
    __device__ __forceinline__ void done(const Unit&) const {}
};
template <class Epi, class Sched, bool STAMP = false>
__device__ __forceinline__ void gemm_phase(PG8_LAS unsigned char* lds, const Gemm g, const Sched& S, const Epi& E, unsigned long long* stamps, int tid_in) {
    const int tid = tid_in, wid = __builtin_amdgcn_readfirstlane(tid >> 6), lane = tid & 63, wr = wid >> 2, wc = wid & 3, fr = lane & 15, fq = lane >> 4;
    const int K = g.K, nt = K / BK;
    int ts_lo = 0, ts_hi = 0, nts = 0; const unsigned long long rt_entry = STAMP ? (unsigned long long)wall_clock64() : 0ull;
#define PG8_STAMP() do { if (STAMP && wid == 0 && nts < 64) { const unsigned long long _c = (unsigned long long)clock64(); \
        ts_lo = (lane == nts) ? (int)(unsigned)_c : ts_lo; ts_hi = (lane == nts) ? (int)(unsigned)(_c >> 32) : ts_hi; ++nts; } } while (0)
    PG8_STAMP();
    unsigned voffA[2], voffB[2];
#pragma unroll
    for (int i = 0; i < 2; ++i) { int R, C; stage_rc(tid * 16 + i * 8192, R, C); const int Rb = Epi::PERM ? ((R & ~31) + perm32(R & 31)) : R;
        voffA[i] = (unsigned)(R * K + C) * 2u; voffB[i] = (unsigned)(Rb * K + C) * 2u; }
    const size_t kstep = (size_t)(BK * 2);
    const size_t hstep = (size_t)HALF * K * 2;
    const size_t tstep = 2 * hstep;
    const unsigned ldsw = (unsigned)wid * 1024u;
    const int aoff = lds_byte(wr * 64 + fr, fq * 8), boff = lds_byte(wc * 32 + fr, fq * 8);
#define PG8_SA(b, h) (((b) * 2 + (h)) * HTB)
#define PG8_SB(b, h) ((4 + (b) * 2 + (h)) * HTB)
#define PG8_STAGE(bufoff, gbase, voff) do { _Pragma("unroll") for (int _i = 0; _i < 2; ++_i) \
        __builtin_amdgcn_global_load_lds((const unsigned*)((const char*)(gbase) + (voff)[_i]), (PG8_LAS unsigned*)(lds + (bufoff) + ldsw + _i * 8192), 16, 0, 0); } while (0)
#define PG8_LDA(dst, b, h) do { _Pragma("unroll") for (int m = 0; m < 4; ++m) _Pragma("unroll") for (int k = 0; k < 2; ++k) dst[m][k] = *(const PG8_LAS bf16x8*)(lds + PG8_SA(b, h) + aoff + m * 2048 + k * 1024); } while (0)
#define PG8_LDB(dst, b, h) do { _Pragma("unroll") for (int n = 0; n < 2; ++n) _Pragma("unroll") for (int k = 0; k < 2; ++k) dst[n][k] = *(const PG8_LAS bf16x8*)(lds + PG8_SB(b, h) + boff + n * 2048 + k * 1024); } while (0)
#define PG8_MMA(ai, bj, At, Bt) do { __builtin_amdgcn_s_setprio(1); _Pragma("unroll") for (int m = 0; m < 4; ++m) _Pragma("unroll") for (int n = 0; n < 2; ++n) _Pragma("unroll") for (int k = 0; k < 2; ++k) \
        acc[ai][bj][m][n] = __builtin_amdgcn_mfma_f32_16x16x32_f16(Bt[n][k], At[m][k], acc[ai][bj][m][n], 0, 0, 0); __builtin_amdgcn_s_setprio(0); } while (0)
#define PG8_WAIT_V(n) asm volatile("s_waitcnt vmcnt(" #n ")" ::: "memory")
#define PG8_WAIT_L(n) asm volatile("s_waitcnt lgkmcnt(" #n ")" ::: "memory")
#define PG8_BAR __builtin_amdgcn_s_barrier()
#define PG8_SCHED __builtin_amdgcn_sched_barrier(0)
    Unit cur, nxt; int ui = 0;
    if (!S.next(0, cur)) return;
    f32x4 acc[2][2][4][2];
#pragma unroll
    for (int a = 0; a < 2; ++a)
#pragma unroll
        for (int b = 0; b < 2; ++b)
#pragma unroll
            for (int m = 0; m < 4; ++m)
#pragma unroll
                for (int n = 0; n < 2; ++n) acc[a][b][m][n] = (f32x4){0.f, 0.f, 0.f, 0.f};
    bf16x8 At[4][2], B0[2][2], B1[2][2];
    const char* cA = (const char*)g.A + (size_t)cur.pm * tstep; const char* cB = (const char*)g.Bt + (size_t)cur.pn * tstep;
    S.a_ready(cur);
    PG8_STAGE(PG8_SB(0, 0), cB, voffB); PG8_STAGE(PG8_SA(0, 0), cA, voffA); PG8_STAGE(PG8_SB(0, 1), cB + hstep, voffB); PG8_STAGE(PG8_SA(0, 1), cA + hstep, voffA);
    if (wr == 1) PG8_BAR;
    PG8_WAIT_V(4); PG8_BAR;
    PG8_STAGE(PG8_SB(1, 0), cB + kstep, voffB); PG8_STAGE(PG8_SA(1, 0), cA + kstep, voffA); PG8_STAGE(PG8_SB(1, 1), cB + hstep + kstep, voffB);
    PG8_WAIT_V(6); PG8_BAR;
    PG8_STAMP();
    for (;;) {
        const bool has_next = S.next(ui + 1, nxt);
        const char* nA = has_next ? (const char*)g.A + (size_t)nxt.pm * tstep : cA; const char* nB = has_next ? (const char*)g.Bt + (size_t)nxt.pn * tstep : cB;
        for (int t = 0; t < nt; t += 2) {
            const bool last = (t == nt - 2);
            const char* a1 = cA + (size_t)(t + 1) * kstep;
            const char* a2 = last ? nA : cA + (size_t)(t + 2) * kstep; const char* b2 = last ? nB : cB + (size_t)(t + 2) * kstep;
            const char* a3 = a2 + kstep; const char* b3 = b2 + kstep;
            if (last && has_next) S.a_ready(nxt);
            PG8_LDB(B0, 0, 0); PG8_SCHED; PG8_LDA(At, 0, 0); PG8_STAGE(PG8_SA(1, 1), a1 + hstep, voffA);
            PG8_WAIT_L(8); PG8_BAR; PG8_WAIT_L(0); PG8_MMA(0, 0, At, B0); PG8_BAR; PG8_SCHED;
            PG8_LDB(B1, 0, 1); PG8_STAGE(PG8_SB(0, 0), b2, voffB);
            PG8_BAR; PG8_WAIT_L(0); PG8_MMA(0, 1, At, B1); PG8_BAR;
            PG8_LDA(At, 0, 1); PG8_STAGE(PG8_SA(0, 0), a2, voffA);
            PG8_BAR; PG8_WAIT_L(0); PG8_MMA(1, 0, At, B0); PG8_BAR; PG8_SCHED;
            PG8_STAGE(PG8_SB(0, 1), b2 + hstep, voffB);
            PG8_WAIT_V(6); PG8_BAR; PG8_MMA(1, 1, At, B1); PG8_BAR;
            PG8_LDB(B0, 1, 0); PG8_SCHED; PG8_LDA(At, 1, 0); PG8_STAGE(PG8_SA(0, 1), a2 + hstep, voffA);
            PG8_WAIT_L(8); PG8_BAR; PG8_WAIT_L(0); PG8_MMA(0, 0, At, B0); PG8_BAR; PG8_SCHED;
            PG8_LDB(B1, 1, 1); PG8_STAGE(PG8_SB(1, 0), b3, voffB);
            PG8_BAR; PG8_WAIT_L(0); PG8_MMA(0, 1, At, B1); PG8_BAR;
            PG8_LDA(At, 1, 1); PG8_STAGE(PG8_SA(1, 0), a3, voffA);
            PG8_BAR; PG8_WAIT_L(0); PG8_MMA(1, 0, At, B0); PG8_BAR; PG8_SCHED;
            PG8_STAGE(PG8_SB(1, 1), b3 + hstep, voffB);
            PG8_WAIT_V(6); PG8_BAR; PG8_MMA(1, 1, At, B1); PG8_BAR;
        }
        PG8_STAMP();
        if constexpr (!Epi::AFTER_DRAIN) { int fr_ = fr, fq_ = fq; asm volatile("" : "+v"(fr_), "+v"(fq_)); E(acc, cur, wr, wc, fr_, fq_); S.done(cur); }
        PG8_STAMP();
        if (!has_next) break;
#pragma unroll
        for (int a = 0; a < 2; ++a)
#pragma unroll
            for (int b = 0; b < 2; ++b)
#pragma unroll
                for (int m = 0; m < 4; ++m)
#pragma unroll
                    for (int n = 0; n < 2; ++n) acc[a][b][m][n] = (f32x4){0.f, 0.f, 0.f, 0.f};
        cur = nxt; cA = nA; cB = nB; ++ui;
    }
    PG8_WAIT_V(0);
    if (wr == 0) PG8_BAR;
    PG8_BAR;
    if constexpr (Epi::AFTER_DRAIN) { E.fused(acc, cur, wr, wc, fr, fq, lds, wid, lane); S.done(cur); }
    PG8_STAMP();
    if (STAMP && wid == 0) { stamps[lane] = lane < nts ? (((unsigned long long)(unsigned)ts_hi << 32) | (unsigned)ts_lo) : 0ull;
        if (lane == 62) stamps[62] = rt_entry; if (lane == 63) stamps[63] = (unsigned long long)wall_clock64(); }
#undef PG8_STAMP
#undef PG8_SA
#undef PG8_SB
#undef PG8_STAGE
#undef PG8_LDA
#undef PG8_LDB
#undef PG8_MMA
#undef PG8_WAIT_V
#undef PG8_WAIT_L
#undef PG8_BAR
#undef PG8_SCHED
}
}

#define LAS __attribute__((address_space(3)))
typedef _Float16 f16;
typedef _Float16 h8 __attribute__((ext_vector_type(8)));
typedef _Float16 h4 __attribute__((ext_vector_type(4)));
typedef _Float16 h2 __attribute__((ext_vector_type(2)));
typedef float f32x4 __attribute__((ext_vector_type(4)));
typedef unsigned u32x2 __attribute__((ext_vector_type(2)));
using pg8::Unit;

constexpr int D = 1024, NTOK = 12288, NCTX = 4096, DFF = 2816, PROJ_LD = 3968, NMIX = 6144, NMIX_REAL = 6016, LORA_K = 384, LORA_N = 5120;
constexpr float ALPHA = 1.189207115002721f;
constexpr size_t MiB = 1048576;
constexpr size_t OFF_MOD = 4096, OFF_INV = 131072, OFF_BC = 917504;
constexpr size_t OFF_LORA = 2 * MiB, OFF_ORWKV = OFF_LORA + 3932160, OFF_OUTW = OFF_ORWKV + 2 * MiB, OFF_PB = OFF_OUTW + 2 * MiB;
constexpr size_t OFF_FFNIN = OFF_PB + 1 * MiB, OFF_FFNOUT = OFF_FFNIN + 11 * MiB, OFF_MIXW = OFF_FFNOUT + 5767168;
constexpr size_t OFF_Y = OFF_FFNIN;
constexpr size_t OFF_X1H = OFF_MIXW + 12 * MiB;
constexpr size_t OFF_H = OFF_X1H + 24 * MiB, OFF_LA = OFF_H, OFF_PR = OFF_H + 9 * MiB;
constexpr size_t OFF_BIG = OFF_H + 24 * MiB;
constexpr size_t OFF_W = OFF_BIG, OFF_A = OFF_BIG + 48 * MiB;
constexpr size_t OFF_R = OFF_BIG + 96 * MiB, OFF_K = OFF_R + 24 * MiB, OFF_V = OFF_K + 24 * MiB;
constexpr size_t WS_END = OFF_V + 24 * MiB;
static_assert(OFF_X1H == 41156608 && WS_END <= 268435456, "workspace map");
constexpr int LDS_TAB = 131072, LDS_BYTES = 131072 + 256;

struct Params { const float* in[28]; float* out; unsigned char* ws; int ph_lo, ph_hi; };

__device__ __forceinline__ float sigmoidf_(float x) { return __builtin_amdgcn_rcpf(1.0f + __expf(-x)); }
__device__ __forceinline__ float siluf_(float x) { return x * __builtin_amdgcn_rcpf(1.0f + __expf(-x)); }
__device__ __forceinline__ f32x4 h4_to_f4(h4 v) { return (f32x4){(float)v[0], (float)v[1], (float)v[2], (float)v[3]}; }
__device__ __forceinline__ h4 f4_to_h4(f32x4 v) { return (h4){(f16)v[0], (f16)v[1], (f16)v[2], (f16)v[3]}; }
__device__ __forceinline__ h8 f8_to_h8(f32x4 a, f32x4 b) { return (h8){(f16)a[0], (f16)a[1], (f16)a[2], (f16)a[3], (f16)b[0], (f16)b[1], (f16)b[2], (f16)b[3]}; }
__device__ __forceinline__ float xor16_sum(float v) { v += __shfl_xor(v, 1); v += __shfl_xor(v, 2); v += __shfl_xor(v, 4); v += __shfl_xor(v, 8); return v; }
__device__ __forceinline__ float wave_sum(float v) {
#pragma unroll
    for (int o = 1; o < 64; o <<= 1) v += __shfl_xor(v, o);
    return v;
}
template <int CTRL> __device__ __forceinline__ float dpp_add(float x) {
    return x + __int_as_float(__builtin_amdgcn_update_dpp(0, __float_as_int(x), CTRL, 0xf, 0xf, false));
}
__device__ __forceinline__ float row16_sum(float x) {
    x = dpp_add<0xB1>(x);
    x = dpp_add<0x4E>(x);
    x = dpp_add<0x141>(x);
    x = dpp_add<0x140>(x);
    return x;
}
__device__ __forceinline__ int mod_index(int row) { return row < NCTX ? 0 : (row < 2 * NCTX ? 1 : 2); }

struct EpiSwiGLU {
    static constexpr bool PERM = true, AFTER_DRAIN = false;
    f16* O;
    __device__ __forceinline__ void operator()(const f32x4 (&acc)[2][2][4][2], const Unit& u, int wr, int wc, int fr, int fq) const {
        const int row0 = u.pm * 256 + wr * 64 + fr, col0 = u.pn * 128 + wc * 32 + 8 * fq;
#pragma unroll
        for (int ai = 0; ai < 2; ++ai)
#pragma unroll
            for (int m = 0; m < 4; ++m) {
                f32x4 o0, o1;
#pragma unroll
                for (int j = 0; j < 4; ++j) { o0[j] = siluf_(acc[ai][0][m][0][j]) * acc[ai][1][m][0][j]; o1[j] = siluf_(acc[ai][0][m][1][j]) * acc[ai][1][m][1][j]; }
                *(h8*)(O + (size_t)(row0 + ai * 128 + m * 16) * DFF + col0) = f8_to_h8(o0, o1);
            }
    }
};
template <int SRC  > struct EpiResid {
    static constexpr bool PERM = false, AFTER_DRAIN = false;
    const float* xa; const float* xb; const f16* xh; float* out; const float* mod; int mg; float coef;
    __device__ __forceinline__ void operator()(const f32x4 (&acc)[2][2][4][2], const Unit& u, int wr, int wc, int fr, int fq) const {
        const int midx = u.pm < 16 ? 0 : (u.pm < 32 ? 1 : 2);
        const float* mrow = mod + (midx * 9 + mg) * D;
        const int row0 = u.pm * 256 + wr * 64 + fr, col0 = u.pn * 256 + wc * 32 + 4 * fq;
#pragma unroll
        for (int ai = 0; ai < 2; ++ai)
#pragma unroll
            for (int m = 0; m < 4; ++m) {
                const int row = row0 + ai * 128 + m * 16;
#pragma unroll
                for (int bj = 0; bj < 2; ++bj)
#pragma unroll
                    for (int n = 0; n < 2; ++n) {
                        const int c = col0 + bj * 128 + n * 16; f32x4 x;
                        const f32x4 mv = *(const f32x4*)(mrow + c) * coef;
                        if (SRC == 0) x = *(const f32x4*)((row < NCTX ? xa + (size_t)row * D : xb + (size_t)(row - NCTX) * D) + c);
                        else if (SRC == 1) x = h4_to_f4(*(const h4*)(xh + (size_t)row * D + c));
                        else x = *(const f32x4*)(out + (size_t)row * D + c);
                        *(f32x4*)(out + (size_t)row * D + c) = x * ALPHA + mv * acc[ai][bj][m][n];
                    }
                asm volatile("" ::: "memory");
            }
    }
};
__device__ __forceinline__ unsigned pack_u8x4(f32x4 v) {
    const unsigned a = (unsigned)(v[0] * 255.0f + 0.5f), b = (unsigned)(v[1] * 255.0f + 0.5f), c = (unsigned)(v[2] * 255.0f + 0.5f), d = (unsigned)(v[3] * 255.0f + 0.5f);
    return a | (b << 8) | (c << 16) | (d << 24);
}
__device__ __forceinline__ f32x4 unpack_u8x4(unsigned w) {
    return (f32x4){(float)(w & 255u), (float)((w >> 8) & 255u), (float)((w >> 16) & 255u), (float)(w >> 24)} * (1.0f / 255.0f);
}
struct EpiMixProj {
    static constexpr bool PERM = true, AFTER_DRAIN = false;
    f16* PS; unsigned char* G8;
    __device__ __forceinline__ void operator()(const f32x4 (&acc)[2][2][4][2], const Unit& u, int wr, int wc, int fr, int fq) const {
        const int row0 = u.pm * 256 + wr * 64 + fr;
#pragma unroll
        for (int bj = 0; bj < 2; ++bj) {
            const int gc0 = u.pn * 256 + bj * 128;
            if (gc0 >= NMIX_REAL) continue;
            const int col = gc0 + wc * 32 + 8 * fq;
#pragma unroll
            for (int ai = 0; ai < 2; ++ai)
#pragma unroll
                for (int m = 0; m < 4; ++m) {
                    const int row = row0 + ai * 128 + m * 16;
                    const f32x4 v0 = acc[ai][bj][m][0], v1 = acc[ai][bj][m][1];
                    if (gc0 < PROJ_LD) *(h8*)(PS + (size_t)row * PROJ_LD + col) = f8_to_h8(v0, v1);
                    else {
                        f32x4 s0, s1;
#pragma unroll
                        for (int j = 0; j < 4; ++j) { s0[j] = sigmoidf_(v0[j]); s1[j] = sigmoidf_(v1[j]); }
                        u32x2 w; w.x = pack_u8x4(s0); w.y = pack_u8x4(s1);
                        *(u32x2*)(G8 + (size_t)row * 2048 + (col - PROJ_LD)) = w;
                    }
                }
        }
    }
};
struct EpiLora {
    static constexpr bool PERM = true, AFTER_DRAIN = false;
    f16* W; f16* A; f16* G; const float* w0; const float* a0;
    template <int MODE> __device__ __forceinline__ void body(const f32x4 (&acc)[2][2][4][2], const Unit& u, int wr, int wc, int fr, int fq, f16* dst, const float* bias) const {
        const int row0 = u.pm * 256 + wr * 64 + fr;
#pragma unroll
        for (int bj = 0; bj < 2; ++bj) {
            const int c = (u.pn & 3) * 256 + bj * 128 + wc * 32 + 8 * fq;
            f32x4 b0 = (f32x4){0.f, 0.f, 0.f, 0.f}, b1 = b0;
            if (MODE < 2) { b0 = *(const f32x4*)(bias + c); b1 = *(const f32x4*)(bias + c + 4); }
#pragma unroll
            for (int ai = 0; ai < 2; ++ai)
#pragma unroll
                for (int m = 0; m < 4; ++m) {
                    const int row = row0 + ai * 128 + m * 16;
                    f32x4 v0 = acc[ai][bj][m][0] + b0, v1 = acc[ai][bj][m][1] + b1;
                    if (MODE == 0) {
#pragma unroll
                        for (int j = 0; j < 4; ++j) { v0[j] = __expf(-0.6065306597126334f * sigmoidf_(v0[j])); v1[j] = __expf(-0.6065306597126334f * sigmoidf_(v1[j])); }
                    } else if (MODE == 1) {
#pragma unroll
                        for (int j = 0; j < 4; ++j) { v0[j] = sigmoidf_(v0[j]); v1[j] = sigmoidf_(v1[j]); }
                    }
                    *(h8*)(dst + (size_t)row * D + c) = f8_to_h8(v0, v1);
                    asm volatile("" ::: "memory");
                }
        }
    }
    __device__ __forceinline__ void operator()(const f32x4 (&acc)[2][2][4][2], const Unit& u, int wr, int wc, int fr, int fq) const {
        const int sec = u.pn >> 2;
        if (sec < 2) body<0>(acc, u, wr, wc, fr, fq, W + (size_t)sec * NTOK * D, w0 + sec * D);
        else if (sec < 4) body<1>(acc, u, wr, wc, fr, fq, A + (size_t)(sec - 2) * NTOK * D, a0 + (sec - 2) * D);
        else body<2>(acc, u, wr, wc, fr, fq, G, nullptr);
    }
};
struct EpiPool {
    static constexpr bool PERM = true, AFTER_DRAIN = false;
    const unsigned char* G8; f16* GBYB;
    __device__ __forceinline__ void operator()(const f32x4 (&acc)[2][2][4][2], const Unit& u, int wr, int wc, int fr, int fq) const {
        const int row0 = u.pm * 256 + wr * 64 + fr;
#pragma unroll
        for (int bj = 0; bj < 2; ++bj) {
            const int c = u.pn * 256 + bj * 128 + wc * 32 + 8 * fq;
#pragma unroll
            for (int ai = 0; ai < 2; ++ai)
#pragma unroll
                for (int m = 0; m < 4; ++m) {
                    const int row = row0 + ai * 128 + m * 16;
                    const u32x2 g = *(const u32x2*)(G8 + (size_t)row * 2048 + 1024 + c);
                    *(h8*)(GBYB + (size_t)row * D + c) = f8_to_h8(unpack_u8x4(g.x) * acc[ai][bj][m][0], unpack_u8x4(g.y) * acc[ai][bj][m][1]);
                }
        }
    }
};
struct EpiMerge {
    static constexpr bool PERM = true, AFTER_DRAIN = false;
    const unsigned char* G8; const f16* GBYB; f16* MG;
    __device__ __forceinline__ void operator()(const f32x4 (&acc)[2][2][4][2], const Unit& u, int wr, int wc, int fr, int fq) const {
        const int row0 = u.pm * 256 + wr * 64 + fr;
#pragma unroll
        for (int bj = 0; bj < 2; ++bj) {
            const int c = u.pn * 256 + bj * 128 + wc * 32 + 8 * fq;
#pragma unroll
            for (int ai = 0; ai < 2; ++ai)
#pragma unroll
                for (int m = 0; m < 4; ++m) {
                    const int row = row0 + ai * 128 + m * 16;
                    const u32x2 g = *(const u32x2*)(G8 + (size_t)row * 2048 + c);
                    const h8 yb = *(const h8*)(GBYB + (size_t)row * D + c);
                    f32x4 o0 = unpack_u8x4(g.x) * acc[ai][bj][m][0], o1 = unpack_u8x4(g.y) * acc[ai][bj][m][1];
#pragma unroll
                    for (int j = 0; j < 4; ++j) { o0[j] += (float)yb[j]; o1[j] += (float)yb[4 + j]; }
                    *(h8*)(MG + (size_t)row * D + c) = f8_to_h8(o0, o1);
                }
        }
    }
};

struct Frame { LAS unsigned char* lds; int tid, lane, wave, G, bid, gw, NGW; };
#define LDS_WAIT() asm volatile("s_waitcnt lgkmcnt(0)" ::: "memory")
__device__ __forceinline__ const float* inp(const Frame& F, int i) {
    const unsigned long long v = *(const LAS unsigned long long*)(F.lds + LDS_TAB + 8 * i);
    const unsigned lo = __builtin_amdgcn_readfirstlane((unsigned)v), hi = __builtin_amdgcn_readfirstlane((unsigned)(v >> 32));
    return (const float*)(((unsigned long long)hi << 32) | lo);
}

template <class Epi> __device__ __forceinline__ void run_gemm(const Frame& F, const void* A, const void* Bt, int N, int K, const Epi& E) {
    pg8::Gemm g{(const pg8::bf16_t*)A, (const pg8::bf16_t*)Bt, NTOK, N, K};
    pg8::StaticOrder S; S.init(NTOK, N, F.G, F.bid);
    pg8::gemm_phase<Epi, pg8::StaticOrder>(F.lds, g, S, E, nullptr, F.tid);
}

__device__ __forceinline__ void tr_item(const float* W, int ldw, int srccol0, int k0, f16* WT, int ldk, int dstrow0, LAS float* scr, int lane) {
#pragma unroll 8
    for (int i = 0; i < 32; ++i) { const int kk = 2 * i + (lane >> 5); scr[kk * 33 + (lane & 31)] = W[(size_t)(k0 + kk) * ldw + srccol0 + (lane & 31)]; }
    LDS_WAIT();
    const int c = lane & 7;
#pragma unroll
    for (int j = 0; j < 4; ++j) { const int n = (lane >> 3) + 8 * j; const LAS float* s = scr + (8 * c) * 33 + n;
        h8 o = (h8){(f16)s[0], (f16)s[33], (f16)s[66], (f16)s[99], (f16)s[132], (f16)s[165], (f16)s[198], (f16)s[231]};
        *(h8*)(WT + (size_t)(dstrow0 + n) * ldk + k0 + 8 * c) = o; }
    LDS_WAIT();
}
__device__ __forceinline__ int ffn_in_srccol(int n0) { const int u = n0 >> 8, i = n0 & 255; return i < 128 ? 128 * u + i : DFF + 128 * u + (i - 128); }
__device__ __forceinline__ void convert_ffn(const Frame& F, const Params& p, int l) {
    LAS float* scr = (LAS float*)(F.lds + F.wave * 8448);
    const float* fin = inp(F, 9) + (size_t)l * D * 2 * DFF; const float* fout = inp(F, 10) + (size_t)l * DFF * D;
    f16* FI = (f16*)(p.ws + OFF_FFNIN); f16* FO = (f16*)(p.ws + OFF_FFNOUT);
    constexpr int I1 = 16 * 176, I2 = 44 * 32;
    for (int it = F.gw; it < I1 + I2; it += F.NGW) {
        if (it < I1) { const int nb = it % 176, kb = it / 176; tr_item(fin, 2 * DFF, ffn_in_srccol(32 * nb), 64 * kb, FI, D, 32 * nb, scr, F.lane); }
        else { const int r = it - I1, nb = r % 32, kb = r / 32; tr_item(fout, D, 32 * nb, 64 * kb, FO, DFF, 32 * nb, scr, F.lane); }
    }
}

__device__ __forceinline__ void p0_prologue(const Frame& F, const Params& p) {
    for (int it = F.bid; it < 144; it += F.G) {
        const int l4 = F.tid & 15, kg = F.tid >> 4;
        const float* wm = inp(F, 5); const float* cc = inp(F, 2); const float* cx = inp(F, 4);
        f32x4 a0 = (f32x4){0.f, 0.f, 0.f, 0.f}, a1 = a0, a2 = a0;
#pragma unroll 4
        for (int kk = 0; kk < 32; ++kk) { const int k = 32 * kg + kk;
            const f32x4 w = *(const f32x4*)(wm + (size_t)k * 9216 + 64 * it + 4 * l4);
            a0 += w * siluf_(cx[k]); a1 += w * siluf_(cc[k]); a2 += w * siluf_(cc[D + k]); }
        LAS float* red = (LAS float*)F.lds;
        *(LAS f32x4*)(red + (kg * 3 + 0) * 64 + 4 * l4) = a0; *(LAS f32x4*)(red + (kg * 3 + 1) * 64 + 4 * l4) = a1; *(LAS f32x4*)(red + (kg * 3 + 2) * 64 + 4 * l4) = a2;
        __syncthreads();
        if (F.tid < 192) { const int i = F.tid >> 6, c = F.tid & 63; float s = 0.f;
            for (int g = 0; g < 32; ++g) s += red[(g * 3 + i) * 64 + c];
            ((float*)(p.ws + OFF_MOD))[i * 9216 + 64 * it + c] = s + inp(F, 6)[64 * it + c]; }
        __syncthreads();
    }
    convert_ffn(F, p, 0);
    {
        LAS float* scr = (LAS float*)(F.lds + F.wave * 8448);
        f16* MX = (f16*)(p.ws + OFF_MIXW); f16* WO = (f16*)(p.ws + OFF_ORWKV); f16* WU = (f16*)(p.ws + OFF_OUTW);
        constexpr int I1 = 16 * 188, I2 = 16 * 32;
        for (int it = F.gw; it < I1 + 2 * I2; it += F.NGW) {
            if (it < I1) { const int nb = it % 188, kb = it / 188; tr_item(inp(F, 11), NMIX_REAL, 32 * nb, 64 * kb, MX, D, 32 * nb, scr, F.lane); }
            else if (it < I1 + I2) { const int r = it - I1, nb = r % 32, kb = r / 32; tr_item(inp(F, 23), D, 32 * nb, 64 * kb, WO, D, 32 * nb, scr, F.lane); }
            else { const int r = it - I1 - I2, nb = r % 32, kb = r / 32; tr_item(inp(F, 27), D, 32 * nb, 64 * kb, WU, D, 32 * nb, scr, F.lane); }
        }
        const int gt = F.bid * 512 + F.tid, NT = F.G * 512;
        for (int i = gt; i < 128 * D / 8; i += NT) *(h8*)(MX + (size_t)NMIX_REAL * D + (size_t)i * 8) = (h8){0, 0, 0, 0, 0, 0, 0, 0};
        f16* LW = (f16*)(p.ws + OFF_LORA);
        for (int i = gt; i < LORA_N * 48; i += NT) {
            const int n = i % LORA_N, k8 = (i / LORA_N) * 8, sec = n >> 10, c = n & 1023;
            const float* src; int koff, klen;
            if (sec == 0) { src = inp(F, 14); koff = 0; klen = 64; } else if (sec == 1) { src = inp(F, 14) + 64 * D; koff = 64; klen = 64; }
            else if (sec == 2) { src = inp(F, 16); koff = 128; klen = 64; } else if (sec == 3) { src = inp(F, 16) + 64 * D; koff = 192; klen = 64; }
            else { src = inp(F, 17); koff = 256; klen = 128; }
            h8 o = (h8){0, 0, 0, 0, 0, 0, 0, 0};
            if (k8 >= koff && k8 < koff + klen) {
#pragma unroll
                for (int e = 0; e < 8; ++e) o[e] = (f16)src[(size_t)(k8 - koff + e) * D + c];
            }
            *(h8*)(LW + (size_t)n * LORA_K + k8) = o;
        }
        f16* PBW = (f16*)(p.ws + OFF_PB);
        for (int i = gt; i < 1024 * 64; i += NT) {
            const int n = i & 1023, k0 = (i >> 10) * 8, g = k0 >> 7, c0 = k0 & 127;
            const float* wp = inp(F, 24) + (size_t)g * 128 * 128 + (size_t)c0 * 128; const float* ps = inp(F, 25) + g * 128; const float* wo = inp(F, 26) + (size_t)g * 128 * D + n;
            float a[8] = {0.f, 0.f, 0.f, 0.f, 0.f, 0.f, 0.f, 0.f};
            for (int d = 0; d < 128; ++d) { const float t = ps[d] * wo[(size_t)d * D];
#pragma unroll
                for (int e = 0; e < 8; ++e) a[e] += wp[e * 128 + d] * t; }
            *(h8*)(PBW + (size_t)n * 512 + k0) = (h8){(f16)a[0], (f16)a[1], (f16)a[2], (f16)a[3], (f16)a[4], (f16)a[5], (f16)a[6], (f16)a[7]};
        }
    }
}

__device__ __forceinline__ void p1_h1(const Frame& F, const Params& p) {
    const float* mod = (const float*)(p.ws + OFF_MOD); f16* H = (f16*)(p.ws + OFF_H);
    for (int row = F.gw; row < NTOK; row += F.NGW) {
        const float* x = row < NCTX ? inp(F, 0) + (size_t)row * D : inp(F, 1) + (size_t)(row - NCTX) * D;
        const float* m0 = mod + (mod_index(row) * 9 + 0) * D; const float* m1 = m0 + D;
#pragma unroll
        for (int j = 0; j < 4; ++j) { const int c = 4 * F.lane + 256 * j;
            const f32x4 v = *(const f32x4*)(x + c), a = *(const f32x4*)(m0 + c), b = *(const f32x4*)(m1 + c);
            *(h4*)(H + (size_t)row * D + c) = f4_to_h4(v * (b + 1.0f) + a); }
    }
}

template <bool WX32, bool WXH, bool WH> __device__ __forceinline__ void ln_phase(const Frame& F, const Params& p, int lni, int mh, int ms) {
    const float* mod = (const float*)(p.ws + OFF_MOD); f16* H = (f16*)(p.ws + OFF_H); f16* XH = (f16*)(p.ws + OFF_X1H);
    const float* g = inp(F, 7) + lni * D; const float* b = inp(F, 8) + lni * D;
    for (int row = F.gw; row < NTOK; row += F.NGW) {
        float* z = p.out + (size_t)row * D;
        f32x4 v[4]; float s = 0.f;
#pragma unroll
        for (int j = 0; j < 4; ++j) { v[j] = *(const f32x4*)(z + 4 * F.lane + 256 * j); s += (v[j][0] + v[j][1]) + (v[j][2] + v[j][3]); }
        const float mean = wave_sum(s) * (1.0f / D); float q = 0.f;
#pragma unroll
        for (int j = 0; j < 4; ++j) { v[j] = v[j] - mean; q += (v[j][0] * v[j][0] + v[j][1] * v[j][1]) + (v[j][2] * v[j][2] + v[j][3] * v[j][3]); }
        const float rstd = 1.0f / sqrtf(wave_sum(q) * (1.0f / D) + 1e-5f);
        const float* mrow = mod + (size_t)mod_index(row) * 9 * D;
#pragma unroll
        for (int j = 0; j < 4; ++j) { const int c = 4 * F.lane + 256 * j;
            const f32x4 x = v[j] * rstd * *(const f32x4*)(g + c) + *(const f32x4*)(b + c);
            if (WX32) *(f32x4*)(z + c) = x;
            if (WXH) *(h4*)(XH + (size_t)row * D + c) = f4_to_h4(x);
            if (WH) *(h4*)(H + (size_t)row * D + c) = f4_to_h4(x * (*(const f32x4*)(mrow + ms * D + c) + 1.0f) + *(const f32x4*)(mrow + mh * D + c)); }
    }
}

struct TokPos { int row, pos, T, lat; };
__device__ __forceinline__ f32x4 shift_mix4(const f16* PS, const float* mu, const TokPos& t, int col) {
    const f16* own = PS + (size_t)t.row * PROJ_LD + col;
    const f32x4 o = h4_to_f4(*(const h4*)own);
    f32x4 sh;
    if (!t.lat) {
        const f32x4 pv = t.pos > 0 ? h4_to_f4(*(const h4*)(own - PROJ_LD)) : (f32x4){0.f, 0.f, 0.f, 0.f};
        const f32x4 nx = t.pos < t.T - 1 ? h4_to_f4(*(const h4*)(own + PROJ_LD)) : (f32x4){0.f, 0.f, 0.f, 0.f};
        sh = (f32x4){pv[0], nx[1], pv[2], nx[3]};
    } else {
        const int gr = t.pos >> 6, gc = t.pos & 63;
        sh[0] = gc > 0 ? (float)own[-PROJ_LD + 0] : 0.f;
        sh[1] = gc < 63 ? (float)own[PROJ_LD + 1] : 0.f;
        sh[2] = gr > 0 ? (float)own[-64 * PROJ_LD + 2] : 0.f;
        sh[3] = gr < 63 ? (float)own[64 * PROJ_LD + 3] : 0.f;
    }
    const f32x4 m = *(const f32x4*)(mu + col);
    return o + m * (sh - o);
}
__device__ __forceinline__ void p6_prep(const Frame& F, const Params& p) {
    const f16* PS = (const f16*)(p.ws + OFF_BIG);
    f16* R = (f16*)(p.ws + OFF_R); f16* K = (f16*)(p.ws + OFF_K); f16* V = (f16*)(p.ws + OFF_V);
    f16* LA = (f16*)(p.ws + OFF_LA); f16* PR = (f16*)(p.ws + OFF_PR);
    float* INV = (float*)(p.ws + OFF_INV); float* BC = (float*)(p.ws + OFF_BC);
    const float* mu = inp(F, 12); const float* k_k = inp(F, 18); const float* r_k = inp(F, 20);
    { const int gt = F.bid * 512 + F.tid, NT = F.G * 512; f32x4* Y4 = (f32x4*)(p.ws + OFF_Y);
      for (int i = gt; i < NTOK * D * 2 / 16; i += NT) Y4[i] = (f32x4){0.f, 0.f, 0.f, 0.f}; }
    for (int row = F.gw; row < NTOK; row += F.NGW) {
        TokPos t; t.row = row;
        if (row < NCTX) { t.lat = 0; t.pos = row & 255; t.T = 256; } else { t.lat = 1; t.pos = (row - NCTX) & 4095; t.T = 4096; }
        const int lane = F.lane;
#pragma unroll 1
        for (int jj = 0; jj < 4; ++jj) {
            const int c = 4 * lane + 256 * jj;
            const f32x4 r = shift_mix4(PS, mu, t, c), k = shift_mix4(PS, mu, t, D + c), v = shift_mix4(PS, mu, t, 2 * D + c);
            *(h4*)(R + (size_t)row * D + c) = f4_to_h4(r); *(h4*)(K + (size_t)row * D + c) = f4_to_h4(k); *(h4*)(V + (size_t)row * D + c) = f4_to_h4(v);
            const f32x4 kk = k * *(const f32x4*)(k_k + c), rk = r * k * *(const f32x4*)(r_k + c);
            const float n2 = xor16_sum((kk[0] * kk[0] + kk[1] * kk[1]) + (kk[2] * kk[2] + kk[3] * kk[3]));
            const float bc = xor16_sum((rk[0] + rk[1]) + (rk[2] + rk[3]));
            if ((lane & 15) == 0) { const int h = 4 * jj + (lane >> 4); INV[row * 16 + h] = 1.0f / fmaxf(sqrtf(n2), 1e-12f); BC[row * 16 + h] = bc; }
        }
        {
            f32x4 x = shift_mix4(PS, mu, t, 3 * D + 4 * lane);
            if (lane < 32) {
#pragma unroll
                for (int j = 0; j < 4; ++j) x[j] = 1.0f - 2.0f * __builtin_amdgcn_rcpf(__expf(2.0f * x[j]) + 1.0f);
            }
            *(h4*)(LA + (size_t)row * LORA_K + 4 * lane) = f4_to_h4(x);
        }
        if (lane < 32) {
            f32x4 x = shift_mix4(PS, mu, t, 3 * D + 256 + 4 * lane);
#pragma unroll
            for (int j = 0; j < 4; ++j) x[j] = sigmoidf_(x[j]);
            *(h4*)(LA + (size_t)row * LORA_K + 256 + 4 * lane) = f4_to_h4(x);
        }
        {
            const int half = 1 << (lane >> 4);
            const int lo = max(t.pos - half, 0), hi = min(t.pos + half, t.T);
            const f16* base = PS + (size_t)(row - t.pos) * PROJ_LD + 3456 + 8 * lane;
            float s[8] = {0.f, 0.f, 0.f, 0.f, 0.f, 0.f, 0.f, 0.f};
            for (int q = lo; q < hi; ++q) { const h8 x = *(const h8*)(base + (size_t)q * PROJ_LD);
#pragma unroll
                for (int e = 0; e < 8; ++e) s[e] += (float)x[e]; }
            const h8 self = *(const h8*)(base + (size_t)t.pos * PROJ_LD);
            const float inv = 1.0f / (float)(hi - lo);
            h8 o;
#pragma unroll
            for (int e = 0; e < 8; ++e) o[e] = (f16)(s[e] * inv - (float)self[e]);
            *(h8*)(PR + (size_t)row * 512 + 8 * lane) = o;
        }
    }
}

struct ScanTask { int active, d, h, rg, seqbase, T, chunk, nch, sidx, lat; };
__device__ __forceinline__ ScanTask scan_task(int grp, int vb, int it) {
    ScanTask t;
    if (grp == 0) { const int chain = vb >> 2; t.active = (it >= 0 && it < 256); t.d = chain >> 5; t.sidx = (chain >> 4) & 1; t.h = chain & 15; t.rg = vb & 3;
        t.seqbase = NCTX + t.sidx * 4096; t.T = 4096; t.chunk = it; t.nch = 256; t.lat = 1; }
    else { const int task = vb * 8 + (it >> 4), chain = task >> 2; t.active = (it >= 0 && it < 128); t.d = chain >> 8; t.sidx = (chain >> 4) & 15; t.h = chain & 15; t.rg = task & 3;
        t.seqbase = t.sidx * 256; t.T = 256; t.chunk = it & 15; t.nch = 16; t.lat = 0; }
    return t;
}
__device__ __forceinline__ int scan_row(const ScanTask& t, int s_) { const int tl = t.chunk * 16 + s_; return t.seqbase + (t.d ? t.T - 1 - tl : tl); }
__device__ __forceinline__ void p8_scan(const Frame& F, const Params& p) {
    const f16* R = (const f16*)(p.ws + OFF_R); const f16* K = (const f16*)(p.ws + OFF_K); const f16* V = (const f16*)(p.ws + OFF_V);
    const f16* Wd = (const f16*)(p.ws + OFF_W); const f16* Ad = (const f16*)(p.ws + OFF_A);
    const float* INV = (const float*)(p.ws + OFF_INV); f16* Y = (f16*)(p.ws + OFF_Y);
    const float* k_k = inp(F, 18); const float* k_a = inp(F, 19); const float* st_in = inp(F, 3); float* st_out = p.out + (size_t)NTOK * D;
    const int grp = F.wave >> 2, gtid = F.tid & 255, gw4 = F.wave & 3, lane = F.lane, ks = lane & 15, rl = gw4 * 4 + (lane >> 4);
    LAS float* sb = (LAS float*)(F.lds + grp * 28672);
    LAS float* sW = sb; LAS float* sKKA = sb + 1024; LAS float* sKD = sb + 2048; LAS float* sR = sb + 3072; LAS float* sKK = sb + 4096; LAS float* sV = sb + 5120; LAS float* yb = sb + 6144;
    for (int vb = F.bid; vb < 256; vb += F.G) {
        f32x4 S = (f32x4){0.f, 0.f, 0.f, 0.f};
        for (int it = 0; it <= 256; ++it) {
            const ScanTask t = scan_task(grp, vb, it);
            if (t.active) {
                const int s_ = gtid >> 4, kq = gtid & 15, row = scan_row(t, s_), col = t.h * 64 + 4 * kq; const size_t o = (size_t)row * D + col;
                const f32x4 r = h4_to_f4(*(const h4*)(R + o)), k = h4_to_f4(*(const h4*)(K + o)), v = h4_to_f4(*(const h4*)(V + o));
                const f32x4 w = h4_to_f4(*(const h4*)(Wd + (size_t)t.d * NTOK * D + o)), a = h4_to_f4(*(const h4*)(Ad + (size_t)t.d * NTOK * D + o));
                const float inv = INV[row * 16 + t.h];
                const f32x4 kk = k * *(const f32x4*)(k_k + col) * inv, kd = k * ((a - 1.0f) * *(const f32x4*)(k_a + col) + 1.0f), kka = kk * a;
                const int so = s_ * 64 + 4 * kq;
                *(LAS f32x4*)(sW + so) = w; *(LAS f32x4*)(sKKA + so) = kka; *(LAS f32x4*)(sKD + so) = kd; *(LAS f32x4*)(sR + so) = r; *(LAS f32x4*)(sKK + so) = kk; *(LAS f32x4*)(sV + so) = v;
            }
            const ScanTask tp = scan_task(grp, vb, it - 1);
            if (tp.active && gtid < 128) {
                const int s_ = gtid >> 3, pr = gtid & 7, row = scan_row(tp, s_);
                const h2 val = (h2){(f16)yb[s_ * 16 + 2 * pr], (f16)yb[s_ * 16 + 2 * pr + 1]};
                __builtin_amdgcn_global_atomic_fadd_v2f16((__attribute__((address_space(1))) h2*)(Y + (size_t)row * D + tp.h * 64 + tp.rg * 16 + 2 * pr), val);
            }
            __syncthreads();
            if (t.active) {
                const int vrow = t.rg * 16 + rl;
                if (t.chunk == 0) {
                    if (t.lat) S = *(const f32x4*)(st_in + ((size_t)((t.sidx * 2 + t.d) * 16 + t.h)) * 4096 + vrow * 64 + 4 * ks);
                    else S = (f32x4){0.f, 0.f, 0.f, 0.f};
                }
#pragma unroll
                for (int s_ = 0; s_ < 16; ++s_) {
                    const f32x4 w = *(const LAS f32x4*)(sW + s_ * 64 + 4 * ks), kka = *(const LAS f32x4*)(sKKA + s_ * 64 + 4 * ks), kd = *(const LAS f32x4*)(sKD + s_ * 64 + 4 * ks);
                    const f32x4 r = *(const LAS f32x4*)(sR + s_ * 64 + 4 * ks), kk = *(const LAS f32x4*)(sKK + s_ * 64 + 4 * ks);
                    const float vv = sV[s_ * 64 + vrow];
                    const f32x4 pk = S * kk;
                    const float sa = row16_sum((pk[0] + pk[1]) + (pk[2] + pk[3]));
                    S = S * w + kd * vv - kka * sa;
                    const f32x4 q = S * r;
                    const float y = row16_sum((q[0] + q[1]) + (q[2] + q[3]));
                    if (ks == 0) yb[s_ * 16 + rl] = y;
                }
                if (!t.lat && t.chunk == t.nch - 1)
                    *(f32x4*)(st_out + ((size_t)((t.sidx * 2 + t.d) * 16 + t.h)) * 4096 + vrow * 64 + 4 * ks) = S;
            }
            __syncthreads();
        }
    }
}

__device__ __forceinline__ void p9_post(const Frame& F, const Params& p) {
    const f16* Y = (const f16*)(p.ws + OFF_Y); const f16* V = (const f16*)(p.ws + OFF_V); const f16* G = (const f16*)((const unsigned char*)p.out + 24 * MiB);
    const float* BC = (const float*)(p.ws + OFF_BC); f16* YO = (f16*)(p.ws + OFF_R);
    const float* lg = inp(F, 21); const float* lb = inp(F, 22);
    for (int row = F.gw; row < NTOK; row += F.NGW) {
#pragma unroll 1
        for (int jj = 0; jj < 4; ++jj) {
            const int c = 4 * F.lane + 256 * jj; const size_t o = (size_t)row * D + c;
            f32x4 y = h4_to_f4(*(const h4*)(Y + o));
            const float mean = xor16_sum((y[0] + y[1]) + (y[2] + y[3])) * (1.0f / 64.0f);
            y = y - mean;
            const float var = xor16_sum((y[0] * y[0] + y[1] * y[1]) + (y[2] * y[2] + y[3] * y[3])) * (1.0f / 64.0f);
            const float rs = 1.0f / sqrtf(var + 64e-5f);
            const float bc = BC[row * 16 + 4 * jj + (F.lane >> 4)];
            const f32x4 v = h4_to_f4(*(const h4*)(V + o)), g = h4_to_f4(*(const h4*)(G + o));
            const f32x4 out = (y * rs * *(const f32x4*)(lg + c) + *(const f32x4*)(lb + c) + v * bc) * g;
            *(h4*)(YO + o) = f4_to_h4(out);
        }
    }
}

__device__ __forceinline__ void grid_bar(unsigned* ctr, unsigned target, int tid) {
    __syncthreads();
    if (tid == 0) {
        __threadfence();
        __hip_atomic_fetch_add(ctr, 1u, __ATOMIC_RELAXED, __HIP_MEMORY_SCOPE_AGENT);
        while (__hip_atomic_load(ctr, __ATOMIC_RELAXED, __HIP_MEMORY_SCOPE_AGENT) < target) __builtin_amdgcn_s_sleep(2);
        __threadfence();
    }
    __syncthreads();
}
__global__ void __launch_bounds__(512, 2) mega_fwd(Params p) {
    extern __shared__ __attribute__((aligned(16))) unsigned char lds_raw[];
    cg::grid_group grid = cg::this_grid();
    Frame F; F.lds = (LAS unsigned char*)lds_raw; F.tid = threadIdx.x; F.lane = F.tid & 63; F.wave = __builtin_amdgcn_readfirstlane(F.tid >> 6);
    F.G = gridDim.x; F.bid = blockIdx.x; F.gw = F.bid * 8 + F.wave; F.NGW = F.G * 8;
    if (F.tid == 0) {
#pragma unroll
        for (int i = 0; i < 28; ++i) *(LAS unsigned long long*)(F.lds + LDS_TAB + 8 * i) = (unsigned long long)p.in[i];
    }
    __syncthreads();
    unsigned char* ws = p.ws; const float* mod = (const float*)(ws + OFF_MOD);
    unsigned char* G8 = (unsigned char*)p.out; f16* Gg = (f16*)((unsigned char*)p.out + 24 * MiB);
#define IN(k) (p.ph_lo <= (k) && (k) < p.ph_hi)
#define SEAM(k) do { if (IN(k) && IN((k) + 1)) { if ((k) == 0) grid.sync(); else grid_bar((unsigned*)ws, (unsigned)(k) * (unsigned)F.G, F.tid); } \
    { int l_; asm volatile("v_mbcnt_lo_u32_b32 %0, -1, 0\n\tv_mbcnt_hi_u32_b32 %0, -1, %0" : "=v"(l_)); F.lane = l_; F.tid = F.wave * 64 + l_; } } while (0)
    if (IN(0)) p0_prologue(F, p);
    SEAM(0);
    if (IN(1)) p1_h1(F, p);
    SEAM(1);
    if (IN(2)) { EpiSwiGLU E{(f16*)(ws + OFF_BIG)}; run_gemm(F, ws + OFF_H, ws + OFF_FFNIN, 2 * DFF, D, E); }
    SEAM(2);
    if (IN(3)) { EpiResid<0> E{inp(F, 0), inp(F, 1), nullptr, p.out, mod, 2, 0.5f}; run_gemm(F, ws + OFF_BIG, ws + OFF_FFNOUT, D, DFF, E); }
    SEAM(3);
    if (IN(4)) ln_phase<false, true, true>(F, p, 0, 3, 4);
    SEAM(4);
    if (IN(5)) { EpiMixProj E{(f16*)(ws + OFF_BIG), G8}; run_gemm(F, ws + OFF_H, ws + OFF_MIXW, NMIX, D, E); }
    SEAM(5);
    if (IN(6)) p6_prep(F, p);
    SEAM(6);
    if (IN(7)) { EpiLora E{(f16*)(ws + OFF_W), (f16*)(ws + OFF_A), Gg, inp(F, 13), inp(F, 15)}; run_gemm(F, ws + OFF_LA, ws + OFF_LORA, LORA_N, LORA_K, E); }
    SEAM(7);
    if (IN(8)) p8_scan(F, p);
    SEAM(8);
    if (IN(9)) { p9_post(F, p); __syncthreads(); EpiPool E{G8, (f16*)(ws + OFF_K)}; run_gemm(F, ws + OFF_PR, ws + OFF_PB, D, 512, E); }
    SEAM(9);
    if (IN(10)) { EpiMerge E{G8, (const f16*)(ws + OFF_K), (f16*)(ws + OFF_BIG)}; run_gemm(F, ws + OFF_R, ws + OFF_ORWKV, D, D, E); }
    SEAM(10);
    if (IN(11)) { EpiResid<1> E{nullptr, nullptr, (const f16*)(ws + OFF_X1H), p.out, mod, 5, 1.0f}; run_gemm(F, ws + OFF_BIG, ws + OFF_OUTW, D, D, E); }
    SEAM(11);
    if (IN(12)) { ln_phase<true, false, true>(F, p, 1, 6, 7); __syncthreads(); convert_ffn(F, p, 1); }
    SEAM(12);
    if (IN(13)) { EpiSwiGLU E{(f16*)(ws + OFF_BIG)}; run_gemm(F, ws + OFF_H, ws + OFF_FFNIN, 2 * DFF, D, E); }
    SEAM(13);
    if (IN(14)) { EpiResid<2> E{nullptr, nullptr, nullptr, p.out, mod, 8, 0.5f}; run_gemm(F, ws + OFF_BIG, ws + OFF_FFNOUT, D, DFF, E); }
    SEAM(14);
    if (IN(15)) ln_phase<true, false, false>(F, p, 2, 0, 0);
}

extern "C" void kernel_launch(void* const* d_in, const int* in_sizes, int n_in, void* d_out, int out_size, void* d_ws, size_t ws_size, hipStream_t stream) {
    static int grid = 0;
    if (grid == 0) {
        if (n_in != 28 || ws_size < WS_END) { fprintf(stderr, "kernel_launch: need 28 inputs and %zu bytes of workspace (got %d, %zu)\n", (size_t)WS_END, n_in, ws_size); grid = -1; return; }
        int dev = 0, cus = 0, per_cu = 0;
        hipGetDevice(&dev); hipDeviceGetAttribute(&cus, hipDeviceAttributeMultiprocessorCount, dev);
        if (hipFuncSetAttribute((const void*)mega_fwd, hipFuncAttributeMaxDynamicSharedMemorySize, LDS_BYTES) != hipSuccess) { fprintf(stderr, "kernel_launch: hipFuncSetAttribute failed\n"); grid = -1; return; }
        if (hipOccupancyMaxActiveBlocksPerMultiprocessor(&per_cu, (const void*)mega_fwd, 512, LDS_BYTES) != hipSuccess || per_cu < 1) { fprintf(stderr, "kernel_launch: occupancy query says %d\n", per_cu); grid = -1; return; }
        grid = cus * per_cu; if (grid > 256) grid = 256;
        fprintf(stderr, "kernel_launch: grid %d (cus %d x %d)\n", grid, cus, per_cu);
    }
    if (grid < 0) return;
    Params p{};
    for (int i = 0; i < 28; ++i) p.in[i] = (const float*)d_in[i];
    p.out = (float*)d_out; p.ws = (unsigned char*)d_ws;
#if MK_MULTI
    for (int ph = 0; ph < 16; ++ph) { p.ph_lo = ph; p.ph_hi = ph + 1; hipLaunchKernelGGL(mega_fwd, dim3(grid), dim3(512), LDS_BYTES, stream, p); }
#else
    p.ph_lo = 0; p.ph_hi = 16;
    if (hipMemsetAsync(d_ws, 0, 256, stream) != hipSuccess) { fprintf(stderr, "kernel_launch: memset failed\n"); return; }
    void* args[] = {&p};
    hipError_t e = hipLaunchCooperativeKernel((const void*)mega_fwd, dim3(grid), dim3(512), args, LDS_BYTES, stream);
    if (e != hipSuccess) fprintf(stderr, "kernel_launch: cooperative launch failed: %s (grid %d)\n", hipGetErrorString(e), grid);
#endif
}
```

```cpp
#include <hip/hip_runtime.h>
#include <hip/hip_cooperative_groups.h>
#include <cstdio>
#include <cstdint>
namespace cg = cooperative_groups;
#ifndef MK_MULTI
#define MK_MULTI 0
#endif
namespace pg8 {
#define PG8_LAS __attribute__((address_space(3)))
typedef unsigned short bf16_t;
typedef _Float16 bf16x8 __attribute__((ext_vector_type(8)));
typedef float f32x4 __attribute__((ext_vector_type(4)));
typedef unsigned u32x4 __attribute__((ext_vector_type(4)));
constexpr int BM = 256, BK = 64, HALF = 128, HTB = HALF * BK * 2  , STAGE_BYTES = 8 * HTB, NXCD = 8, WGM = 8;

__host__ __device__ __forceinline__ int lds_byte(int r, int c) { const int st = (r >> 4) * 2 + (c >> 5), rr = r & 15, cc = c & 31, ob = rr * 64 + cc * 2; return st * 1024 + (ob ^ (((ob >> 9) & 1) << 5)); }
__host__ __device__ __forceinline__ void stage_rc(int b, int& R, int& C) { const int st = b / 1024, sb = b % 1024, swz = sb ^ (((sb >> 9) & 1) << 5); R = (st >> 1) * 16 + swz / 64; C = (st & 1) * 32 + (swz % 64) / 2; }
__host__ __device__ __forceinline__ int perm32(int rho) { const int n = rho >> 4, i = rho & 15; return 8 * (i >> 2) + 4 * n + (i & 3); }

struct Unit { int pm, pn; };
struct Gemm { const bf16_t* A; const bf16_t* Bt; int M, N, K; };

struct StaticOrder {
    int nM, nN, nwg, G, c;
    __host__ __device__ void init(int M, int N, int G_, int c_) { nM = M / BM; nN = N / BM; nwg = nM * nN; G = G_; c = c_; }
    __host__ __device__ bool next(int i, Unit& u) const {
        const long L = (long)i * G + c; if (L >= nwg) return false;
        int wgid = (int)L; { const int q = nwg / NXCD, r = nwg % NXCD, xcd = wgid % NXCD, off = wgid / NXCD; wgid = (xcd < r ? xcd * (q + 1) : r * (q + 1) + (xcd - r) * q) + off; }
        const int nig = WGM * nN, gid = wgid / nig, fm = gid * WGM, gsz = (nM - fm) < WGM ? (nM - fm) : WGM;
        u.pm = fm + ((wgid % nig) % gsz); u.pn = (wgid % nig) / gsz; return true;
    }
    __device__ __forceinline__ void a_ready(const Unit&) const {}
    __device__ __forceinline__ void done(const Unit&) const {}
};
template <class Epi, class Sched, bool STAMP = false>
__device__ __forceinline__ void gemm_phase(PG8_LAS unsigned char* lds, const Gemm g, const Sched& S, const Epi& E, unsigned long long* stamps, int tid_in) {
    const int tid = tid_in, wid = __builtin_amdgcn_readfirstlane(tid >> 6), lane = tid & 63, wr = wid >> 2, wc = wid & 3, fr = lane & 15, fq = lane >> 4;
    const int K = g.K, nt = K / BK;
    int ts_lo = 0, ts_hi = 0, nts = 0; const unsigned long long rt_entry = STAMP ? (unsigned long long)wall_clock64() : 0ull;
#define PG8_STAMP() do { if (STAMP && wid == 0 && nts < 64) { const unsigned long long _c = (unsigned long long)clock64(); \
        ts_lo = (lane == nts) ? (int)(unsigned)_c : ts_lo; ts_hi = (lane == nts) ? (int)(unsigned)(_c >> 32) : ts_hi; ++nts; } } while (0)
    PG8_STAMP();
    unsigned voffA[2], voffB[2];
#pragma unroll
    for (int i = 0; i < 2; ++i) { int R, C; stage_rc(tid * 16 + i * 8192, R, C); const int Rb = Epi::PERM ? ((R & ~31) + perm32(R & 31)) : R;
        voffA[i] = (unsigned)(R * K + C) * 2u; voffB[i] = (unsigned)(Rb * K + C) * 2u; }
    const size_t kstep = (size_t)(BK * 2);
    const size_t hstep = (size_t)HALF * K * 2;
    const size_t tstep = 2 * hstep;
    const unsigned ldsw = (unsigned)wid * 1024u;
    const int aoff = lds_byte(wr * 64 + fr, fq * 8), boff = lds_byte(wc * 32 + fr, fq * 8);
#define PG8_SA(b, h) (((b) * 2 + (h)) * HTB)
#define PG8_SB(b, h) ((4 + (b) * 2 + (h)) * HTB)
#define PG8_STAGE(bufoff, gbase, voff) do { _Pragma("unroll") for (int _i = 0; _i < 2; ++_i) \
        __builtin_amdgcn_global_load_lds((const unsigned*)((const char*)(gbase) + (voff)[_i]), (PG8_LAS unsigned*)(lds + (bufoff) + ldsw + _i * 8192), 16, 0, 0); } while (0)
#define PG8_LDA(dst, b, h) do { _Pragma("unroll") for (int m = 0; m < 4; ++m) _Pragma("unroll") for (int k = 0; k < 2; ++k) dst[m][k] = *(const PG8_LAS bf16x8*)(lds + PG8_SA(b, h) + aoff + m * 2048 + k * 1024); } while (0)
#define PG8_LDB(dst, b, h) do { _Pragma("unroll") for (int n = 0; n < 2; ++n) _Pragma("unroll") for (int k = 0; k < 2; ++k) dst[n][k] = *(const PG8_LAS bf16x8*)(lds + PG8_SB(b, h) + boff + n * 2048 + k * 1024); } while (0)
#define PG8_MMA(ai, bj, At, Bt) do { __builtin_amdgcn_s_setprio(1); _Pragma("unroll") for (int m = 0; m < 4; ++m) _Pragma("unroll") for (int n = 0; n < 2; ++n) _Pragma("unroll") for (int k = 0; k < 2; ++k) \
        acc[ai][bj][m][n] = __builtin_amdgcn_mfma_f32_16x16x32_f16(Bt[n][k], At[m][k], acc[ai][bj][m][n], 0, 0, 0); __builtin_amdgcn_s_setprio(0); } while (0)
#define PG8_WAIT_V(n) asm volatile("s_waitcnt vmcnt(" #n ")" ::: "memory")
#define PG8_WAIT_L(n) asm volatile("s_waitcnt lgkmcnt(" #n ")" ::: "memory")
#define PG8_BAR __builtin_amdgcn_s_barrier()
#define PG8_SCHED __builtin_amdgcn_sched_barrier(0)
    Unit cur, nxt; int ui = 0;
    if (!S.next(0, cur)) return;
    f32x4 acc[2][2][4][2];
#pragma unroll
    for (int a = 0; a < 2; ++a)
#pragma unroll
        for (int b = 0; b < 2; ++b)
#pragma unroll
            for (int m = 0; m < 4; ++m)
#pragma unroll
                for (int n = 0; n < 2; ++n) acc[a][b][m][n] = (f32x4){0.f, 0.f, 0.f, 0.f};
    bf16x8 At[4][2], B0[2][2], B1[2][2];
    const char* cA = (const char*)g.A + (size_t)cur.pm * tstep; const char* cB = (const char*)g.Bt + (size_t)cur.pn * tstep;
    S.a_ready(cur);
    PG8_STAGE(PG8_SB(0, 0), cB, voffB); PG8_STAGE(PG8_SA(0, 0), cA, voffA); PG8_STAGE(PG8_SB(0, 1), cB + hstep, voffB); PG8_STAGE(PG8_SA(0, 1), cA + hstep, voffA);
    if (wr == 1) PG8_BAR;
    PG8_WAIT_V(4); PG8_BAR;
    PG8_STAGE(PG8_SB(1, 0), cB + kstep, voffB); PG8_STAGE(PG8_SA(1, 0), cA + kstep, voffA); PG8_STAGE(PG8_SB(1, 1), cB + hstep + kstep, voffB);
    PG8_WAIT_V(6); PG8_BAR;
    PG8_STAMP();
    for (;;) {
        const bool has_next = S.next(ui + 1, nxt);
        const char* nA = has_next ? (const char*)g.A + (size_t)nxt.pm * tstep : cA; const char* nB = has_next ? (const char*)g.Bt + (size_t)nxt.pn * tstep : cB;
        for (int t = 0; t < nt; t += 2) {
            const bool last = (t == nt - 2);
            const char* a1 = cA + (size_t)(t + 1) * kstep;
            const char* a2 = last ? nA : cA + (size_t)(t + 2) * kstep; const char* b2 = last ? nB : cB + (size_t)(t + 2) * kstep;
            const char* a3 = a2 + kstep; const char* b3 = b2 + kstep;
            if (last && has_next) S.a_ready(nxt);
            PG8_LDB(B0, 0, 0); PG8_SCHED; PG8_LDA(At, 0, 0); PG8_STAGE(PG8_SA(1, 1), a1 + hstep, voffA);
            PG8_WAIT_L(8); PG8_BAR; PG8_WAIT_L(0); PG8_MMA(0, 0, At, B0); PG8_BAR; PG8_SCHED;
            PG8_LDB(B1, 0, 1); PG8_STAGE(PG8_SB(0, 0), b2, voffB);
            PG8_BAR; PG8_WAIT_L(0); PG8_MMA(0, 1, At, B1); PG8_BAR;
            PG8_LDA(At, 0, 1); PG8_STAGE(PG8_SA(0, 0), a2, voffA);
            PG8_BAR; PG8_WAIT_L(0); PG8_MMA(1, 0, At, B0); PG8_BAR; PG8_SCHED;
            PG8_STAGE(PG8_SB(0, 1), b2 + hstep, voffB);
            PG8_WAIT_V(6); PG8_BAR; PG8_MMA(1, 1, At, B1); PG8_BAR;
            PG8_LDB(B0, 1, 0); PG8_SCHED; PG8_LDA(At, 1, 0); PG8_STAGE(PG8_SA(0, 1), a2 + hstep, voffA);
            PG8_WAIT_L(8); PG8_BAR; PG8_WAIT_L(0); PG8_MMA(0, 0, At, B0); PG8_BAR; PG8_SCHED;
            PG8_LDB(B1, 1, 1); PG8_STAGE(PG8_SB(1, 0), b3, voffB);
            PG8_BAR; PG8_WAIT_L(0); PG8_MMA(0, 1, At, B1); PG8_BAR;
            PG8_LDA(At, 1, 1); PG8_STAGE(PG8_SA(1, 0), a3, voffA);
            PG8_BAR; PG8_WAIT_L(0); PG8_MMA(1, 0, At, B0); PG8_BAR; PG8_SCHED;
            PG8_STAGE(PG8_SB(1, 1), b3 + hstep, voffB);
            PG8_WAIT_V(6); PG8_BAR; PG8_MMA(1, 1, At, B1); PG8_BAR;
        }
        PG8_STAMP();
        if constexpr (!Epi::AFTER_DRAIN) { int fr_ = fr, fq_ = fq; asm volatile("" : "+v"(fr_), "+v"(fq_)); E(acc, cur, wr, wc, fr_, fq_); S.done(cur); }
        PG8_STAMP();
        if (!has_next) break;
#pragma unroll
        for (int a = 0; a < 2; ++a)
#pragma unroll
            for (int b = 0; b < 2; ++b)
#pragma unroll
                for (int m = 0; m < 4; ++m)
#pragma unroll
                    for (int n = 0; n < 2; ++n) acc[a][b][m][n] = (f32x4){0.f, 0.f, 0.f, 0.f};
        cur = nxt; cA = nA; cB = nB; ++ui;
    }
    PG8_WAIT_V(0);
    if (wr == 0) PG8_BAR;
    PG8_BAR;
    if constexpr (Epi::AFTER_DRAIN) { E.fused(acc, cur, wr, wc, fr, fq, lds, wid, lane); S.done(cur); }
    PG8_STAMP();
    if (STAMP && wid == 0) { stamps[lane] = lane < nts ? (((unsigned long long)(unsigned)ts_hi << 32) | (unsigned)ts_lo) : 0ull;
        if (lane == 62) stamps[62] = rt_entry; if (lane == 63) stamps[63] = (unsigned long long)wall_clock64(); }
#undef PG8_STAMP
#undef PG8_SA
#undef PG8_SB
#undef PG8_STAGE
#undef PG8_LDA
#undef PG8_LDB
#undef PG8_MMA
#undef PG8_WAIT_V
#undef PG8_WAIT_L
#undef PG8_BAR
#undef PG8_SCHED
}
}
#define LAS __attribute__((address_space(3)))
#define XB_TMO      128
#define XB_XCNT(j)  (256  + 64 * (j))
#define XB_XSUB(j)  (1280 + 64 * (j))
#define XB_XGEN(j)  (2304 + 64 * (j))
#define XB_TOP      3328
#define XB_TOPGEN   3392
#define XCD_BAR_WORDS 3456
#define XB_SPIN_CAP (1u << 18)

__device__ __forceinline__ unsigned xb_ld(unsigned* p)              { return __hip_atomic_load(p, __ATOMIC_RELAXED, __HIP_MEMORY_SCOPE_AGENT); }
__device__ __forceinline__ unsigned xb_add(unsigned* p, unsigned v) { return __hip_atomic_fetch_add(p, v, __ATOMIC_RELAXED, __HIP_MEMORY_SCOPE_AGENT); }
__device__ __forceinline__ unsigned xb_xcc_id() { return (unsigned)__builtin_amdgcn_s_getreg((3 << 11) | 20) & 0xFu; }
#define XB_SPIN(cond, bar) do { unsigned _sp = 0; while (cond) { __builtin_amdgcn_s_sleep(1); \
    if ((++_sp & 255u) == 0u) { if (xb_ld(&(bar)[XB_TMO])) break; if (_sp > XB_SPIN_CAP) { atomicAdd(&(bar)[XB_TMO], 1u); break; } } } } while (0)

struct XcdBarrier {
    unsigned* bar; unsigned x;
    volatile LAS unsigned* st;
};

__device__ __forceinline__ XcdBarrier xcd_barrier_post(unsigned* bar, volatile LAS unsigned* st, int tid) {
    XcdBarrier b; b.bar = bar; b.x = xb_xcc_id(); b.st = st;
    if (tid == 0) (void)xb_add(&bar[XB_XCNT(b.x)], 1u);
    return b;
}
__device__ __forceinline__ void xcd_barrier_complete(unsigned* bar, unsigned x, unsigned& nloc, unsigned& nx) {
    const unsigned G = gridDim.x * gridDim.y * gridDim.z;
    unsigned sum, cnt, mine, sp = 0u;
    for (;;) {
        sum = 0u; cnt = 0u; mine = 0u;
#pragma unroll
        for (unsigned j = 0; j < 16; ++j) { const unsigned c = xb_ld(&bar[XB_XCNT(j)]); sum += c; cnt += (c > 0u) ? 1u : 0u; mine = (j == x) ? c : mine; }
        if (sum == G) break;
        __builtin_amdgcn_s_sleep(1);
        if ((++sp & 255u) == 0u) { if (xb_ld(&bar[XB_TMO])) break; if (sp > XB_SPIN_CAP) { atomicAdd(&bar[XB_TMO], 1u); break; } }
    }
    nloc = mine > 0u ? mine : 1u; nx = cnt > 0u ? cnt : 1u;
}

__device__ __forceinline__ void xcd_barrier(const XcdBarrier& b, int tid) {
    asm volatile("s_waitcnt vmcnt(0)" ::: "memory");
    __syncthreads();
    if (tid == 0) {
        unsigned* bar = b.bar;
        __builtin_amdgcn_s_waitcnt(0);
        unsigned nloc = b.st[0], nx = b.st[1];
        if (nloc == 0u) { xcd_barrier_complete(bar, b.x, nloc, nx); b.st[0] = nloc; b.st[1] = nx; }
        const unsigned old = xb_add(&bar[XB_XSUB(b.x)], 1u);
        const unsigned gen = old / nloc;
        if (old + 1u == (gen + 1u) * nloc) {
            __builtin_amdgcn_fence(__ATOMIC_RELEASE, "agent");
            asm volatile("s_waitcnt vmcnt(0)" ::: "memory");
            const unsigned og = xb_add(&bar[XB_TOP], 1u);
            const unsigned tg = og / nx;
            if (og + 1u == (tg + 1u) * nx) xb_add(&bar[XB_TOPGEN], 1u);
            else XB_SPIN(xb_ld(&bar[XB_TOPGEN]) == tg, bar);
            __builtin_amdgcn_fence(__ATOMIC_ACQUIRE, "agent");
            xb_add(&bar[XB_XGEN(b.x)], 1u);
            asm volatile("s_waitcnt vmcnt(0)" ::: "memory");
        } else {
            XB_SPIN(xb_ld(&bar[XB_XGEN(b.x)]) == gen, bar);
            __builtin_amdgcn_fence(__ATOMIC_ACQUIRE, "agent");
            asm volatile("s_waitcnt vmcnt(0)" ::: "memory");
        }
    }
    __syncthreads();
}


typedef _Float16 f16;
typedef _Float16 h8 __attribute__((ext_vector_type(8)));
typedef _Float16 h4 __attribute__((ext_vector_type(4)));
typedef _Float16 h2 __attribute__((ext_vector_type(2)));
typedef float f32x4 __attribute__((ext_vector_type(4)));
typedef unsigned u32x2 __attribute__((ext_vector_type(2)));
using pg8::Unit;

constexpr int D = 1024, NTOK = 12288, NCTX = 4096, DFF = 2816, PROJ_LD = 3968, NMIX = 6144, NMIX_REAL = 6016, LORA_K = 384, LORA_N = 5120;
constexpr float ALPHA = 1.189207115002721f;
constexpr size_t MiB = 1048576;
constexpr size_t OFF_MOD = 16384, OFF_INV = 131072, OFF_BC = 917504;
constexpr size_t OFF_LORA = 2 * MiB, OFF_ORWKV = OFF_LORA + 3932160, OFF_OUTW = OFF_ORWKV + 2 * MiB, OFF_PB = OFF_OUTW + 2 * MiB;
constexpr size_t OFF_FFNIN = OFF_PB + 1 * MiB, OFF_FFNOUT = OFF_FFNIN + 11 * MiB, OFF_MIXW = OFF_FFNOUT + 5767168;
constexpr size_t OFF_Y = OFF_FFNIN;
constexpr size_t OFF_X1H = OFF_MIXW + 12 * MiB;
constexpr size_t OFF_H = OFF_X1H + 24 * MiB, OFF_LA = OFF_H, OFF_PR = OFF_H + 9 * MiB;
constexpr size_t OFF_BIG = OFF_H + 24 * MiB;
constexpr size_t OFF_W = OFF_BIG, OFF_A = OFF_BIG + 48 * MiB;
constexpr size_t OFF_R = OFF_BIG + 96 * MiB, OFF_K = OFF_R + 24 * MiB, OFF_V = OFF_K + 24 * MiB;
constexpr size_t WS_END = OFF_V + 24 * MiB;
static_assert(OFF_X1H == 41156608 && WS_END <= 268435456, "workspace map");
constexpr int LDS_TAB = 131072, LDS_XB = 131072 + 240, LDS_BYTES = 131072 + 256;

struct Params { const float* in[28]; float* out; unsigned char* ws; int ph_lo, ph_hi; };

__device__ __forceinline__ float sigmoidf_(float x) { return __builtin_amdgcn_rcpf(1.0f + __expf(-x)); }
__device__ __forceinline__ float siluf_(float x) { return x * __builtin_amdgcn_rcpf(1.0f + __expf(-x)); }
__device__ __forceinline__ f32x4 h4_to_f4(h4 v) { return (f32x4){(float)v[0], (float)v[1], (float)v[2], (float)v[3]}; }
__device__ __forceinline__ h4 f4_to_h4(f32x4 v) { return (h4){(f16)v[0], (f16)v[1], (f16)v[2], (f16)v[3]}; }
__device__ __forceinline__ h8 f8_to_h8(f32x4 a, f32x4 b) { return (h8){(f16)a[0], (f16)a[1], (f16)a[2], (f16)a[3], (f16)b[0], (f16)b[1], (f16)b[2], (f16)b[3]}; }
__device__ __forceinline__ float xor16_sum(float v) { v += __shfl_xor(v, 1); v += __shfl_xor(v, 2); v += __shfl_xor(v, 4); v += __shfl_xor(v, 8); return v; }
__device__ __forceinline__ float wave_sum(float v) {
#pragma unroll
    for (int o = 1; o < 64; o <<= 1) v += __shfl_xor(v, o);
    return v;
}
template <int CTRL> __device__ __forceinline__ float dpp_add(float x) {
    return x + __int_as_float(__builtin_amdgcn_update_dpp(0, __float_as_int(x), CTRL, 0xf, 0xf, false));
}
__device__ __forceinline__ float row16_sum(float x) {
    x = dpp_add<0xB1>(x);
    x = dpp_add<0x4E>(x);
    x = dpp_add<0x141>(x);
    x = dpp_add<0x140>(x);
    return x;
}
__device__ __forceinline__ int mod_index(int row) { return row < NCTX ? 0 : (row < 2 * NCTX ? 1 : 2); }

struct EpiSwiGLU {
    static constexpr bool PERM = true, AFTER_DRAIN = false;
    f16* O;
    __device__ __forceinline__ void operator()(const f32x4 (&acc)[2][2][4][2], const Unit& u, int wr, int wc, int fr, int fq) const {
        const int row0 = u.pm * 256 + wr * 64 + fr, col0 = u.pn * 128 + wc * 32 + 8 * fq;
#pragma unroll
        for (int ai = 0; ai < 2; ++ai)
#pragma unroll
            for (int m = 0; m < 4; ++m) {
                f32x4 o0, o1;
#pragma unroll
                for (int j = 0; j < 4; ++j) { o0[j] = siluf_(acc[ai][0][m][0][j]) * acc[ai][1][m][0][j]; o1[j] = siluf_(acc[ai][0][m][1][j]) * acc[ai][1][m][1][j]; }
                *(h8*)(O + (size_t)(row0 + ai * 128 + m * 16) * DFF + col0) = f8_to_h8(o0, o1);
            }
    }
};
template <int SRC  > struct EpiResid {
    static constexpr bool PERM = false, AFTER_DRAIN = false;
    const float* xa; const float* xb; const f16* xh; float* out; const float* mod; int mg; float coef;
    __device__ __forceinline__ void operator()(const f32x4 (&acc)[2][2][4][2], const Unit& u, int wr, int wc, int fr, int fq) const {
        const int midx = u.pm < 16 ? 0 : (u.pm < 32 ? 1 : 2);
        const float* mrow = mod + (midx * 9 + mg) * D;
        const int row0 = u.pm * 256 + wr * 64 + fr, col0 = u.pn * 256 + wc * 32 + 4 * fq;
#pragma unroll
        for (int ai = 0; ai < 2; ++ai)
#pragma unroll
            for (int m = 0; m < 4; ++m) {
                const int row = row0 + ai * 128 + m * 16;
#pragma unroll
                for (int bj = 0; bj < 2; ++bj)
#pragma unroll
                    for (int n = 0; n < 2; ++n) {
                        const int c = col0 + bj * 128 + n * 16; f32x4 x;
                        const f32x4 mv = *(const f32x4*)(mrow + c) * coef;
                        if (SRC == 0) x = *(const f32x4*)((row < NCTX ? xa + (size_t)row * D : xb + (size_t)(row - NCTX) * D) + c);
                        else if (SRC == 1) x = h4_to_f4(*(const h4*)(xh + (size_t)row * D + c));
                        else x = *(const f32x4*)(out + (size_t)row * D + c);
                        *(f32x4*)(out + (size_t)row * D + c) = x * ALPHA + mv * acc[ai][bj][m][n];
                    }
                asm volatile("" ::: "memory");
            }
    }
};
__device__ __forceinline__ unsigned pack_u8x4(f32x4 v) {
    const unsigned a = (unsigned)(v[0] * 255.0f + 0.5f), b = (unsigned)(v[1] * 255.0f + 0.5f), c = (unsigned)(v[2] * 255.0f + 0.5f), d = (unsigned)(v[3] * 255.0f + 0.5f);
    return a | (b << 8) | (c << 16) | (d << 24);
}
__device__ __forceinline__ f32x4 unpack_u8x4(unsigned w) {
    return (f32x4){(float)(w & 255u), (float)((w >> 8) & 255u), (float)((w >> 16) & 255u), (float)(w >> 24)} * (1.0f / 255.0f);
}
struct EpiMixProj {
    static constexpr bool PERM = true, AFTER_DRAIN = false;
    f16* PS; unsigned char* G8;
    __device__ __forceinline__ void operator()(const f32x4 (&acc)[2][2][4][2], const Unit& u, int wr, int wc, int fr, int fq) const {
        const int row0 = u.pm * 256 + wr * 64 + fr;
#pragma unroll
        for (int bj = 0; bj < 2; ++bj) {
            const int gc0 = u.pn * 256 + bj * 128;
            if (gc0 >= NMIX_REAL) continue;
            const int col = gc0 + wc * 32 + 8 * fq;
#pragma unroll
            for (int ai = 0; ai < 2; ++ai)
#pragma unroll
                for (int m = 0; m < 4; ++m) {
                    const int row = row0 + ai * 128 + m * 16;
                    const f32x4 v0 = acc[ai][bj][m][0], v1 = acc[ai][bj][m][1];
                    if (gc0 < PROJ_LD) *(h8*)(PS + (size_t)row * PROJ_LD + col) = f8_to_h8(v0, v1);
                    else {
                        f32x4 s0, s1;
#pragma unroll
                        for (int j = 0; j < 4; ++j) { s0[j] = sigmoidf_(v0[j]); s1[j] = sigmoidf_(v1[j]); }
                        u32x2 w; w.x = pack_u8x4(s0); w.y = pack_u8x4(s1);
                        *(u32x2*)(G8 + (size_t)row * 2048 + (col - PROJ_LD)) = w;
                    }
                }
        }
    }
};
struct EpiLora {
    static constexpr bool PERM = true, AFTER_DRAIN = false;
    f16* W; f16* A; f16* G; const float* w0; const float* a0;
    __device__ __forceinline__ void operator()(const f32x4 (&acc)[2][2][4][2], const Unit& u, int wr, int wc, int fr, int fq) const {
        const int sec = u.pn >> 2, row0 = u.pm * 256 + wr * 64 + fr;
        f16* dst = sec < 2 ? W + (size_t)sec * NTOK * D : (sec < 4 ? A + (size_t)(sec - 2) * NTOK * D : G);
        const float* bias = sec < 2 ? w0 + sec * D : a0 + (sec & 1) * D;
        const float bsc = sec < 4 ? 1.0f : 0.0f;
#pragma unroll
        for (int bj = 0; bj < 2; ++bj) {
            const int c = (u.pn & 3) * 256 + bj * 128 + wc * 32 + 8 * fq;
            const f32x4 b0 = *(const f32x4*)(bias + c) * bsc, b1 = *(const f32x4*)(bias + c + 4) * bsc;
#pragma unroll
            for (int ai = 0; ai < 2; ++ai)
#pragma unroll
                for (int m = 0; m < 4; ++m) {
                    const int row = row0 + ai * 128 + m * 16;
                    f32x4 v0 = acc[ai][bj][m][0] + b0, v1 = acc[ai][bj][m][1] + b1;
#pragma unroll
                    for (int j = 0; j < 4; ++j) {
                        const float s0 = sigmoidf_(v0[j]), s1 = sigmoidf_(v1[j]);
                        const float e0 = __expf(-0.6065306597126334f * s0), e1 = __expf(-0.6065306597126334f * s1);
                        v0[j] = sec < 2 ? e0 : (sec < 4 ? s0 : v0[j]); v1[j] = sec < 2 ? e1 : (sec < 4 ? s1 : v1[j]);
                    }
                    *(h8*)(dst + (size_t)row * D + c) = f8_to_h8(v0, v1);
                    __builtin_amdgcn_sched_barrier(0);
                }
        }
    }
};
struct EpiPool {
    static constexpr bool PERM = true, AFTER_DRAIN = false;
    const unsigned char* G8; f16* GBYB;
    __device__ __forceinline__ void operator()(const f32x4 (&acc)[2][2][4][2], const Unit& u, int wr, int wc, int fr, int fq) const {
        const int row0 = u.pm * 256 + wr * 64 + fr;
#pragma unroll
        for (int bj = 0; bj < 2; ++bj) {
            const int c = u.pn * 256 + bj * 128 + wc * 32 + 8 * fq;
#pragma unroll
            for (int ai = 0; ai < 2; ++ai)
#pragma unroll
                for (int m = 0; m < 4; ++m) {
                    const int row = row0 + ai * 128 + m * 16;
                    const u32x2 g = *(const u32x2*)(G8 + (size_t)row * 2048 + 1024 + c);
                    *(h8*)(GBYB + (size_t)row * D + c) = f8_to_h8(unpack_u8x4(g.x) * acc[ai][bj][m][0], unpack_u8x4(g.y) * acc[ai][bj][m][1]);
                }
        }
    }
};
struct EpiMerge {
    static constexpr bool PERM = true, AFTER_DRAIN = false;
    const unsigned char* G8; const f16* GBYB; f16* MG;
    __device__ __forceinline__ void operator()(const f32x4 (&acc)[2][2][4][2], const Unit& u, int wr, int wc, int fr, int fq) const {
        const int row0 = u.pm * 256 + wr * 64 + fr;
#pragma unroll
        for (int bj = 0; bj < 2; ++bj) {
            const int c = u.pn * 256 + bj * 128 + wc * 32 + 8 * fq;
#pragma unroll
            for (int ai = 0; ai < 2; ++ai)
#pragma unroll
                for (int m = 0; m < 4; ++m) {
                    const int row = row0 + ai * 128 + m * 16;
                    const u32x2 g = *(const u32x2*)(G8 + (size_t)row * 2048 + c);
                    const h8 yb = *(const h8*)(GBYB + (size_t)row * D + c);
                    f32x4 o0 = unpack_u8x4(g.x) * acc[ai][bj][m][0], o1 = unpack_u8x4(g.y) * acc[ai][bj][m][1];
#pragma unroll
                    for (int j = 0; j < 4; ++j) { o0[j] += (float)yb[j]; o1[j] += (float)yb[4 + j]; }
                    *(h8*)(MG + (size_t)row * D + c) = f8_to_h8(o0, o1);
                }
        }
    }
};

struct Frame { LAS unsigned char* lds; int tid, lane, wave, G, bid, gw, NGW, epoch; };
#define LDS_WAIT() asm volatile("s_waitcnt lgkmcnt(0)" ::: "memory")
__device__ __forceinline__ const float* inp(const Frame& F, int i) {
    const unsigned long long v = *(const LAS unsigned long long*)(F.lds + LDS_TAB + 8 * i);
    const unsigned lo = __builtin_amdgcn_readfirstlane((unsigned)v), hi = __builtin_amdgcn_readfirstlane((unsigned)(v >> 32));
    return (const float*)(((unsigned long long)hi << 32) | lo);
}

template <class Epi> __device__ __forceinline__ void run_gemm(const Frame& F, const void* A, const void* Bt, int N, int K, const Epi& E) {
    asm volatile("" : "+s"(K));
    pg8::Gemm g{(const pg8::bf16_t*)A, (const pg8::bf16_t*)Bt, NTOK, N, K};
    pg8::StaticOrder S; S.init(NTOK, N, F.G, F.bid);
    pg8::gemm_phase<Epi, pg8::StaticOrder>(F.lds, g, S, E, nullptr, F.tid);
}

__device__ __forceinline__ void tr_item(const float* W, int ldw, int srccol0, int k0, f16* WT, int ldk, int dstrow0, LAS float* scr, int lane) {
#pragma unroll
    for (int i = 0; i < 32; ++i) { const int kk = 2 * i + (lane >> 5); scr[kk * 33 + (lane & 31)] = W[(size_t)(k0 + kk) * ldw + srccol0 + (lane & 31)]; }
    LDS_WAIT();
    const int c = lane & 7;
#pragma unroll
    for (int j = 0; j < 4; ++j) { const int n = (lane >> 3) + 8 * j; const LAS float* s = scr + (8 * c) * 33 + n;
        h8 o = (h8){(f16)s[0], (f16)s[33], (f16)s[66], (f16)s[99], (f16)s[132], (f16)s[165], (f16)s[198], (f16)s[231]};
        *(h8*)(WT + (size_t)(dstrow0 + n) * ldk + k0 + 8 * c) = o; }
    LDS_WAIT();
}
__device__ __forceinline__ int ffn_in_srccol(int n0) { const int u = n0 >> 8, i = n0 & 255; return i < 128 ? 128 * u + i : DFF + 128 * u + (i - 128); }
__device__ __forceinline__ void convert_ffn(const Frame& F, const Params& p, int l) {
    LAS float* scr = (LAS float*)(F.lds + F.wave * 8448);
    const float* fin = inp(F, 9) + (size_t)l * D * 2 * DFF; const float* fout = inp(F, 10) + (size_t)l * DFF * D;
    f16* FI = (f16*)(p.ws + OFF_FFNIN); f16* FO = (f16*)(p.ws + OFF_FFNOUT);
    constexpr int I1 = 16 * 176, I2 = 44 * 32;
    for (int it = F.gw; it < I1 + I2; it += F.NGW) {
        if (it < I1) { const int nb = it % 176, kb = it / 176; tr_item(fin, 2 * DFF, ffn_in_srccol(32 * nb), 64 * kb, FI, D, 32 * nb, scr, F.lane); }
        else { const int r = it - I1, nb = r % 32, kb = r / 32; tr_item(fout, D, 32 * nb, 64 * kb, FO, DFF, 32 * nb, scr, F.lane); }
    }
}

__device__ __forceinline__ void p0_prologue(const Frame& F, const Params& p) {
    for (int it = F.bid; it < 144; it += F.G) {
        const int l4 = F.tid & 15, kg = F.tid >> 4;
        const float* wm = inp(F, 5); const float* cc = inp(F, 2); const float* cx = inp(F, 4);
        f32x4 a0 = (f32x4){0.f, 0.f, 0.f, 0.f}, a1 = a0, a2 = a0;
#pragma unroll 4
        for (int kk = 0; kk < 32; ++kk) { const int k = 32 * kg + kk;
            const f32x4 w = *(const f32x4*)(wm + (size_t)k * 9216 + 64 * it + 4 * l4);
            a0 += w * siluf_(cx[k]); a1 += w * siluf_(cc[k]); a2 += w * siluf_(cc[D + k]); }
        LAS float* red = (LAS float*)F.lds;
        *(LAS f32x4*)(red + (kg * 3 + 0) * 64 + 4 * l4) = a0; *(LAS f32x4*)(red + (kg * 3 + 1) * 64 + 4 * l4) = a1; *(LAS f32x4*)(red + (kg * 3 + 2) * 64 + 4 * l4) = a2;
        __syncthreads();
        if (F.tid < 192) { const int i = F.tid >> 6, c = F.tid & 63; float s = 0.f;
            for (int g = 0; g < 32; ++g) s += red[(g * 3 + i) * 64 + c];
            ((float*)(p.ws + OFF_MOD))[i * 9216 + 64 * it + c] = s + inp(F, 6)[64 * it + c]; }
        __syncthreads();
    }
    convert_ffn(F, p, 0);
    {
        LAS float* scr = (LAS float*)(F.lds + F.wave * 8448);
        f16* MX = (f16*)(p.ws + OFF_MIXW); f16* WO = (f16*)(p.ws + OFF_ORWKV); f16* WU = (f16*)(p.ws + OFF_OUTW);
        constexpr int I1 = 16 * 188, I2 = 16 * 32;
        for (int it = F.gw; it < I1 + 2 * I2; it += F.NGW) {
            if (it < I1) { const int nb = it % 188, kb = it / 188; tr_item(inp(F, 11), NMIX_REAL, 32 * nb, 64 * kb, MX, D, 32 * nb, scr, F.lane); }
            else if (it < I1 + I2) { const int r = it - I1, nb = r % 32, kb = r / 32; tr_item(inp(F, 23), D, 32 * nb, 64 * kb, WO, D, 32 * nb, scr, F.lane); }
            else { const int r = it - I1 - I2, nb = r % 32, kb = r / 32; tr_item(inp(F, 27), D, 32 * nb, 64 * kb, WU, D, 32 * nb, scr, F.lane); }
        }
        const int gt = F.bid * 512 + F.tid, NT = F.G * 512;
        for (int i = gt; i < 128 * D / 8; i += NT) *(h8*)(MX + (size_t)NMIX_REAL * D + (size_t)i * 8) = (h8){0, 0, 0, 0, 0, 0, 0, 0};
        f16* LW = (f16*)(p.ws + OFF_LORA);
        for (int i = gt; i < LORA_N * 48; i += NT) {
            const int n = i % LORA_N, k8 = (i / LORA_N) * 8, sec = n >> 10, c = n & 1023;
            const float* src; int koff, klen;
            if (sec == 0) { src = inp(F, 14); koff = 0; klen = 64; } else if (sec == 1) { src = inp(F, 14) + 64 * D; koff = 64; klen = 64; }
            else if (sec == 2) { src = inp(F, 16); koff = 128; klen = 64; } else if (sec == 3) { src = inp(F, 16) + 64 * D; koff = 192; klen = 64; }
            else { src = inp(F, 17); koff = 256; klen = 128; }
            h8 o = (h8){0, 0, 0, 0, 0, 0, 0, 0};
            if (k8 >= koff && k8 < koff + klen) {
#pragma unroll
                for (int e = 0; e < 8; ++e) o[e] = (f16)src[(size_t)(k8 - koff + e) * D + c];
            }
            *(h8*)(LW + (size_t)n * LORA_K + k8) = o;
        }
        f16* PBW = (f16*)(p.ws + OFF_PB);
        for (int i = gt; i < 1024 * 64; i += NT) {
            const int n = i & 1023, k0 = (i >> 10) * 8, g = k0 >> 7, c0 = k0 & 127;
            const float* wp = inp(F, 24) + (size_t)g * 128 * 128 + (size_t)c0 * 128; const float* ps = inp(F, 25) + g * 128; const float* wo = inp(F, 26) + (size_t)g * 128 * D + n;
            float a[8] = {0.f, 0.f, 0.f, 0.f, 0.f, 0.f, 0.f, 0.f};
#pragma unroll 8
            for (int d = 0; d < 128; ++d) { const float t = ps[d] * wo[(size_t)d * D];
#pragma unroll
                for (int e = 0; e < 8; ++e) a[e] += wp[e * 128 + d] * t; }
            *(h8*)(PBW + (size_t)n * 512 + k0) = (h8){(f16)a[0], (f16)a[1], (f16)a[2], (f16)a[3], (f16)a[4], (f16)a[5], (f16)a[6], (f16)a[7]};
        }
    }
}

__device__ __forceinline__ void p1_h1(const Frame& F, const Params& p) {
    const float* mod = (const float*)(p.ws + OFF_MOD); f16* H = (f16*)(p.ws + OFF_H);
    for (int row = F.gw; row < NTOK; row += F.NGW) {
        const float* x = row < NCTX ? inp(F, 0) + (size_t)row * D : inp(F, 1) + (size_t)(row - NCTX) * D;
        const float* m0 = mod + (mod_index(row) * 9 + 0) * D; const float* m1 = m0 + D;
#pragma unroll
        for (int j = 0; j < 4; ++j) { const int c = 4 * F.lane + 256 * j;
            const f32x4 v = *(const f32x4*)(x + c), a = *(const f32x4*)(m0 + c), b = *(const f32x4*)(m1 + c);
            *(h4*)(H + (size_t)row * D + c) = f4_to_h4(v * (b + 1.0f) + a); }
    }
}

template <bool WX32, bool WXH, bool WH> __device__ __forceinline__ void ln_phase(const Frame& F, const Params& p, int lni, int mh, int ms) {
    const float* mod = (const float*)(p.ws + OFF_MOD); f16* H = (f16*)(p.ws + OFF_H); f16* XH = (f16*)(p.ws + OFF_X1H);
    const float* g = inp(F, 7) + lni * D; const float* b = inp(F, 8) + lni * D;
    for (int row = F.gw; row < NTOK; row += F.NGW) {
        float* z = p.out + (size_t)row * D;
        f32x4 v[4]; float s = 0.f;
#pragma unroll
        for (int j = 0; j < 4; ++j) { v[j] = *(const f32x4*)(z + 4 * F.lane + 256 * j); s += (v[j][0] + v[j][1]) + (v[j][2] + v[j][3]); }
        const float mean = wave_sum(s) * (1.0f / D); float q = 0.f;
#pragma unroll
        for (int j = 0; j < 4; ++j) { v[j] = v[j] - mean; q += (v[j][0] * v[j][0] + v[j][1] * v[j][1]) + (v[j][2] * v[j][2] + v[j][3] * v[j][3]); }
        const float rstd = 1.0f / sqrtf(wave_sum(q) * (1.0f / D) + 1e-5f);
        const float* mrow = mod + (size_t)mod_index(row) * 9 * D;
#pragma unroll
        for (int j = 0; j < 4; ++j) { const int c = 4 * F.lane + 256 * j;
            const f32x4 x = v[j] * rstd * *(const f32x4*)(g + c) + *(const f32x4*)(b + c);
            if (WX32) *(f32x4*)(z + c) = x;
            if (WXH) *(h4*)(XH + (size_t)row * D + c) = f4_to_h4(x);
            if (WH) *(h4*)(H + (size_t)row * D + c) = f4_to_h4(x * (*(const f32x4*)(mrow + ms * D + c) + 1.0f) + *(const f32x4*)(mrow + mh * D + c)); }
    }
}

struct TokPos { int row, pos, T, lat; };
__device__ __forceinline__ f32x4 shift_mix4(const f16* PS, const float* mu, const TokPos& t, int col) {
    const f16* own = PS + (size_t)t.row * PROJ_LD + col;
    const f32x4 o = h4_to_f4(*(const h4*)own);
    f32x4 sh;
    if (!t.lat) {
        const f32x4 pv = t.pos > 0 ? h4_to_f4(*(const h4*)(own - PROJ_LD)) : (f32x4){0.f, 0.f, 0.f, 0.f};
        const f32x4 nx = t.pos < t.T - 1 ? h4_to_f4(*(const h4*)(own + PROJ_LD)) : (f32x4){0.f, 0.f, 0.f, 0.f};
        sh = (f32x4){pv[0], nx[1], pv[2], nx[3]};
    } else {
        const int gr = t.pos >> 6, gc = t.pos & 63;
        sh[0] = gc > 0 ? (float)own[-PROJ_LD + 0] : 0.f;
        sh[1] = gc < 63 ? (float)own[PROJ_LD + 1] : 0.f;
        sh[2] = gr > 0 ? (float)own[-64 * PROJ_LD + 2] : 0.f;
        sh[3] = gr < 63 ? (float)own[64 * PROJ_LD + 3] : 0.f;
    }
    const f32x4 m = *(const f32x4*)(mu + col);
    return o + m * (sh - o);
}
__device__ __forceinline__ void p6_prep(const Frame& F, const Params& p) {
    const f16* PS = (const f16*)(p.ws + OFF_BIG);
    f16* R = (f16*)(p.ws + OFF_R); f16* K = (f16*)(p.ws + OFF_K); f16* V = (f16*)(p.ws + OFF_V);
    f16* LA = (f16*)(p.ws + OFF_LA); f16* PR = (f16*)(p.ws + OFF_PR);
    float* INV = (float*)(p.ws + OFF_INV); float* BC = (float*)(p.ws + OFF_BC);
    const float* mu = inp(F, 12); const float* k_k = inp(F, 18); const float* r_k = inp(F, 20);
    { const int gt = F.bid * 512 + F.tid, NT = F.G * 512; f32x4* Y4 = (f32x4*)(p.ws + OFF_Y);
      for (int i = gt; i < NTOK * D * 2 / 16; i += NT) Y4[i] = (f32x4){0.f, 0.f, 0.f, 0.f}; }
    for (int row = F.gw; row < NTOK; row += F.NGW) {
        TokPos t; t.row = row;
        if (row < NCTX) { t.lat = 0; t.pos = row & 255; t.T = 256; } else { t.lat = 1; t.pos = (row - NCTX) & 4095; t.T = 4096; }
        const int lane = F.lane;
#pragma unroll
        for (int jj = 0; jj < 4; ++jj) {
            const int c = 4 * lane + 256 * jj;
            const f32x4 r = shift_mix4(PS, mu, t, c), k = shift_mix4(PS, mu, t, D + c), v = shift_mix4(PS, mu, t, 2 * D + c);
            *(h4*)(R + (size_t)row * D + c) = f4_to_h4(r); *(h4*)(K + (size_t)row * D + c) = f4_to_h4(k); *(h4*)(V + (size_t)row * D + c) = f4_to_h4(v);
            const f32x4 kk = k * *(const f32x4*)(k_k + c), rk = r * k * *(const f32x4*)(r_k + c);
            const float n2 = xor16_sum((kk[0] * kk[0] + kk[1] * kk[1]) + (kk[2] * kk[2] + kk[3] * kk[3]));
            const float bc = xor16_sum((rk[0] + rk[1]) + (rk[2] + rk[3]));
            if ((lane & 15) == 0) { const int h = 4 * jj + (lane >> 4); INV[row * 16 + h] = 1.0f / fmaxf(sqrtf(n2), 1e-12f); BC[row * 16 + h] = bc; }
        }
        {
            f32x4 x = shift_mix4(PS, mu, t, 3 * D + 4 * lane);
            if (lane < 32) {
#pragma unroll
                for (int j = 0; j < 4; ++j) x[j] = 1.0f - 2.0f * __builtin_amdgcn_rcpf(__expf(2.0f * x[j]) + 1.0f);
            }
            *(h4*)(LA + (size_t)row * LORA_K + 4 * lane) = f4_to_h4(x);
        }
        if (lane < 32) {
            f32x4 x = shift_mix4(PS, mu, t, 3 * D + 256 + 4 * lane);
#pragma unroll
            for (int j = 0; j < 4; ++j) x[j] = sigmoidf_(x[j]);
            *(h4*)(LA + (size_t)row * LORA_K + 256 + 4 * lane) = f4_to_h4(x);
        }
        {
            const int half = 1 << (lane >> 4);
            const int lo = max(t.pos - half, 0), hi = min(t.pos + half, t.T);
            const f16* base = PS + (size_t)(row - t.pos) * PROJ_LD + 3456 + 8 * lane;
            float s[8] = {0.f, 0.f, 0.f, 0.f, 0.f, 0.f, 0.f, 0.f};
#pragma unroll
            for (int qq = 0; qq < 16; ++qq) { const int q = lo + qq;
                if (q < hi) { const h8 x = *(const h8*)(base + (size_t)q * PROJ_LD);
#pragma unroll
                    for (int e = 0; e < 8; ++e) s[e] += (float)x[e]; } }
            const h8 self = *(const h8*)(base + (size_t)t.pos * PROJ_LD);
            const float inv = 1.0f / (float)(hi - lo);
            h8 o;
#pragma unroll
            for (int e = 0; e < 8; ++e) o[e] = (f16)(s[e] * inv - (float)self[e]);
            *(h8*)(PR + (size_t)row * 512 + 8 * lane) = o;
        }
    }
}

__device__ __forceinline__ int scan_desc(int grp, int vb, int it) {
    int dsc;
    if (grp == 0) { const int chain = vb >> 2; dsc = ((it >= 0 && it < 256) ? 1 : 0) | ((chain >> 5) << 1) | ((chain & 15) << 2) | ((vb & 3) << 6) | (((chain >> 4) & 1) << 8) | ((it & 255) << 12) | (1 << 20); }
    else { const int task = vb * 8 + ((it >> 4) & 7), chain = task >> 2; dsc = ((it >= 0 && it < 128) ? 1 : 0) | ((chain >> 8) << 1) | ((chain & 15) << 2) | ((task & 3) << 6) | (((chain >> 4) & 15) << 8) | ((it & 15) << 12); }
    dsc = __builtin_amdgcn_readfirstlane(dsc);
    asm volatile("" : "+s"(dsc));
    return dsc;
}
#define SD_ACT(x) ((x) & 1)
#define SD_D(x) (((x) >> 1) & 1)
#define SD_H(x) (((x) >> 2) & 15)
#define SD_RG(x) (((x) >> 6) & 3)
#define SD_SIDX(x) (((x) >> 8) & 15)
#define SD_CHUNK(x) (((x) >> 12) & 255)
#define SD_LAT(x) (((x) >> 20) & 1)
__device__ __forceinline__ int scan_row(int dsc, int s_) {
    const int lat = SD_LAT(dsc), T = lat ? 4096 : 256, seqbase = lat ? NCTX + SD_SIDX(dsc) * 4096 : SD_SIDX(dsc) * 256, tl = SD_CHUNK(dsc) * 16 + s_;
    return seqbase + (SD_D(dsc) ? T - 1 - tl : tl);
}
__device__ __forceinline__ void p8_scan(const Frame& F, const Params& p) {
    const int grp = F.wave >> 2, gtid = F.tid & 255, gw4 = F.wave & 3, lane = F.lane, ks = lane & 15, rl = gw4 * 4 + (lane >> 4);
    LAS float* gb = (LAS float*)(F.lds + grp * 53248);
    const int s_st = gtid >> 4, kq = gtid & 15;
    unsigned char* ws = p.ws;
    for (int vb = F.bid; vb < 256; vb += F.G) {
        f32x4 S = (f32x4){0.f, 0.f, 0.f, 0.f};
        h4 q_r = (h4){0, 0, 0, 0}, q_k = q_r, q_v = q_r, q_w = q_r, q_a = q_r; float q_inv = 0.f; f32x4 q_kk = (f32x4){0.f, 0.f, 0.f, 0.f}, q_ka = q_kk;
        for (int it = -1; it <= 256; ++it) {
            const int tn = scan_desc(grp, vb, it + 1);
            if (SD_ACT(tn)) {
                const int row = scan_row(tn, s_st), col = SD_H(tn) * 64 + 4 * kq; const size_t o = ((size_t)row * D + col) * 2;
                q_r = *(const h4*)(ws + OFF_R + o); q_k = *(const h4*)(ws + OFF_K + o); q_v = *(const h4*)(ws + OFF_V + o);
                const size_t od = o + (size_t)SD_D(tn) * NTOK * D * 2;
                q_w = *(const h4*)(ws + OFF_W + od); q_a = *(const h4*)(ws + OFF_A + od);
                q_inv = ((const float*)(ws + OFF_INV))[row * 16 + SD_H(tn)]; q_kk = *(const f32x4*)(inp(F, 18) + col); q_ka = *(const f32x4*)(inp(F, 19) + col);
            }
            const int tp = scan_desc(grp, vb, it - 1);
            if (SD_ACT(tp) && gtid < 128) {
                const LAS float* yb = gb + 12288 + ((it - 1) & 1) * 256;
                const int s_ = gtid >> 3, pr = gtid & 7, row = scan_row(tp, s_);
                const h2 val = (h2){(f16)yb[s_ * 16 + 2 * pr], (f16)yb[s_ * 16 + 2 * pr + 1]};
                __builtin_amdgcn_global_atomic_fadd_v2f16((__attribute__((address_space(1))) h2*)(ws + OFF_Y + ((size_t)row * D + SD_H(tp) * 64 + SD_RG(tp) * 16 + 2 * pr) * 2), val);
            }
            const int t = scan_desc(grp, vb, it);
            if (SD_ACT(t)) {
                const LAS float* sb = gb + (it & 1) * 6144;
                const int vrow = SD_RG(t) * 16 + rl;
                const size_t so_ = ((size_t)((SD_SIDX(t) * 2 + SD_D(t)) * 16 + SD_H(t))) * 4096 + vrow * 64 + 4 * ks;
                if (SD_CHUNK(t) == 0) {
                    if (SD_LAT(t)) S = *(const f32x4*)(inp(F, 3) + so_);
                    else S = (f32x4){0.f, 0.f, 0.f, 0.f};
                }
                float yacc = 0.f;
#pragma unroll
                for (int s_ = 0; s_ < 16; ++s_) {
                    const f32x4 w = *(const LAS f32x4*)(sb + s_ * 64 + 4 * ks), kka = *(const LAS f32x4*)(sb + 1024 + s_ * 64 + 4 * ks), kd = *(const LAS f32x4*)(sb + 2048 + s_ * 64 + 4 * ks);
                    const f32x4 r = *(const LAS f32x4*)(sb + 3072 + s_ * 64 + 4 * ks), kk = *(const LAS f32x4*)(sb + 4096 + s_ * 64 + 4 * ks);
                    const float vv = sb[5120 + s_ * 64 + vrow];
                    const f32x4 pk = S * kk;
                    const float sa = row16_sum((pk[0] + pk[1]) + (pk[2] + pk[3]));
                    S = S * w + kd * vv - kka * sa;
                    const f32x4 q = S * r;
                    const float y = row16_sum((q[0] + q[1]) + (q[2] + q[3]));
                    yacc = (ks == s_) ? y : yacc;
                }
                gb[12288 + (it & 1) * 256 + ks * 16 + rl] = yacc;
                if (!SD_LAT(t) && SD_CHUNK(t) == 15)
                    *(f32x4*)(p.out + (size_t)NTOK * D + so_) = S;
            }
            if (SD_ACT(tn)) {
                LAS float* sb = gb + ((it + 1) & 1) * 6144;
                const f32x4 r = h4_to_f4(q_r), k = h4_to_f4(q_k), v = h4_to_f4(q_v), w = h4_to_f4(q_w), a = h4_to_f4(q_a);
                const f32x4 kk = k * q_kk * q_inv, kd = k * ((a - 1.0f) * q_ka + 1.0f), kka = kk * a;
                const int so = s_st * 64 + 4 * kq;
                *(LAS f32x4*)(sb + so) = w; *(LAS f32x4*)(sb + 1024 + so) = kka; *(LAS f32x4*)(sb + 2048 + so) = kd; *(LAS f32x4*)(sb + 3072 + so) = r; *(LAS f32x4*)(sb + 4096 + so) = kk; *(LAS f32x4*)(sb + 5120 + so) = v;
            }
            __syncthreads();
        }
    }
}

__device__ __forceinline__ void p9_post(const Frame& F, const Params& p) {
    const f16* Y = (const f16*)(p.ws + OFF_Y); const f16* V = (const f16*)(p.ws + OFF_V); const f16* G = (const f16*)((const unsigned char*)p.out + 24 * MiB);
    const float* BC = (const float*)(p.ws + OFF_BC); f16* YO = (f16*)(p.ws + OFF_R);
    const float* lg = inp(F, 21); const float* lb = inp(F, 22);
    for (int row = F.gw; row < NTOK; row += F.NGW) {
#pragma unroll 1
        for (int jj = 0; jj < 4; ++jj) {
            const int c = 4 * F.lane + 256 * jj; const size_t o = (size_t)row * D + c;
            f32x4 y = h4_to_f4(*(const h4*)(Y + o));
            const float mean = xor16_sum((y[0] + y[1]) + (y[2] + y[3])) * (1.0f / 64.0f);
            y = y - mean;
            const float var = xor16_sum((y[0] * y[0] + y[1] * y[1]) + (y[2] * y[2] + y[3] * y[3])) * (1.0f / 64.0f);
            const float rs = 1.0f / sqrtf(var + 64e-5f);
            const float bc = BC[row * 16 + 4 * jj + (F.lane >> 4)];
            const f32x4 v = h4_to_f4(*(const h4*)(V + o)), g = h4_to_f4(*(const h4*)(G + o));
            const f32x4 out = (y * rs * *(const f32x4*)(lg + c) + *(const f32x4*)(lb + c) + v * bc) * g;
            *(h4*)(YO + o) = f4_to_h4(out);
        }
    }
}

__global__ void __launch_bounds__(512, 2) mega_fwd(Params p) {
    extern __shared__ __attribute__((aligned(16))) unsigned char lds_raw[];
    cg::grid_group grid = cg::this_grid();
    Frame F; F.lds = (LAS unsigned char*)lds_raw; F.tid = threadIdx.x; F.lane = F.tid & 63; F.wave = __builtin_amdgcn_readfirstlane(F.tid >> 6);
    F.epoch = 0; F.G = gridDim.x; F.bid = blockIdx.x; F.gw = F.bid * 8 + F.wave; F.NGW = F.G * 8;
    if (F.tid == 0) {
#pragma unroll
        for (int i = 0; i < 28; ++i) *(LAS unsigned long long*)(F.lds + LDS_TAB + 8 * i) = (unsigned long long)p.in[i];
    }
    __syncthreads();
    unsigned char* ws = p.ws; const float* mod = (const float*)(ws + OFF_MOD);
    unsigned char* G8 = (unsigned char*)p.out; f16* Gg = (f16*)((unsigned char*)p.out + 24 * MiB);
#ifndef REP_G
#define REP_G 1
#endif
#ifndef REP_B
#define REP_B 1
#endif
#ifndef REP_S
#define REP_S 1
#endif
#ifndef REP_E
#define REP_E 0
#endif
#define IN(k) (p.ph_lo <= (k) && (k) < p.ph_hi)
#define SEAM(k) do { if (IN(k) && IN((k) + 1)) { for (int rb_ = 0; rb_ < REP_B; ++rb_) xcd_barrier(xbar, F.tid); } \
    { int l_; asm volatile("v_mbcnt_lo_u32_b32 %0, -1, 0\n\tv_mbcnt_hi_u32_b32 %0, -1, %0" : "=v"(l_)); F.lane = l_; F.tid = F.wave * 64 + l_; } } while (0)
    if (p.ph_hi == 0x7fffffff) grid.sync();
    if (F.tid == 0) { *(LAS unsigned*)(F.lds + LDS_XB) = 0u; *(LAS unsigned*)(F.lds + LDS_XB + 4) = 0u; }
    __syncthreads();
    XcdBarrier xbar = xcd_barrier_post((unsigned*)ws, (volatile LAS unsigned*)(F.lds + LDS_XB), F.tid);
    { int l_; asm volatile("v_mbcnt_lo_u32_b32 %0, -1, 0\n\tv_mbcnt_hi_u32_b32 %0, -1, %0" : "=v"(l_)); F.lane = l_; F.tid = F.wave * 64 + l_; }
    if (IN(0)) for (int rep_ = 0; rep_ < ((REP_E & 1) ? 2 : 1); ++rep_) { p0_prologue(F, p); __syncthreads(); }
    SEAM(0);
    if (IN(1)) for (int rep_ = 0; rep_ < ((REP_E & 2) ? 2 : 1); ++rep_) p1_h1(F, p);
    SEAM(1);
    if (IN(2)) { EpiSwiGLU E{(f16*)(ws + OFF_BIG)}; run_gemm(F, ws + OFF_H, ws + OFF_FFNIN, 2 * DFF, D, E); if (REP_G > 1) { run_gemm(F, ws + OFF_H, ws + OFF_FFNIN, 2 * DFF, D, E); } }
    SEAM(2);
    if (IN(3)) { EpiResid<0> E{inp(F, 0), inp(F, 1), nullptr, p.out, mod, 2, 0.5f}; run_gemm(F, ws + OFF_BIG, ws + OFF_FFNOUT, D, DFF, E); if (REP_G > 1) { run_gemm(F, ws + OFF_BIG, ws + OFF_FFNOUT, D, DFF, E); } }
    SEAM(3);
    if (IN(4)) for (int rep_ = 0; rep_ < ((REP_E & 4) ? 2 : 1); ++rep_) ln_phase<false, true, true>(F, p, 0, 3, 4);
    SEAM(4);
    if (IN(5)) { EpiMixProj E{(f16*)(ws + OFF_BIG), G8}; run_gemm(F, ws + OFF_H, ws + OFF_MIXW, NMIX, D, E); if (REP_G > 1) { run_gemm(F, ws + OFF_H, ws + OFF_MIXW, NMIX, D, E); } }
    SEAM(5);
    if (IN(6)) for (int rep_ = 0; rep_ < ((REP_E & 8) ? 2 : 1); ++rep_) p6_prep(F, p);
    SEAM(6);
    if (IN(7)) { EpiLora E{(f16*)(ws + OFF_W), (f16*)(ws + OFF_A), Gg, inp(F, 13), inp(F, 15)}; run_gemm(F, ws + OFF_LA, ws + OFF_LORA, LORA_N, LORA_K, E); if (REP_G > 1) { run_gemm(F, ws + OFF_LA, ws + OFF_LORA, LORA_N, LORA_K, E); } }
    SEAM(7);
    if (IN(8)) p8_scan(F, p);
#if REP_S > 1
    xcd_barrier(xbar, F.tid);
    { const int gt = F.bid * 512 + F.tid, NT = F.G * 512; f32x4* Y4 = (f32x4*)(p.ws + OFF_Y);
      for (int i = gt; i < NTOK * D * 2 / 16; i += NT) Y4[i] = (f32x4){0.f, 0.f, 0.f, 0.f}; }
    xcd_barrier(xbar, F.tid);
    p8_scan(F, p);
#endif
    SEAM(8);
    if (IN(9)) { for (int rep_ = 0; rep_ < ((REP_E & 16) ? 2 : 1); ++rep_) p9_post(F, p); __syncthreads(); EpiPool E{G8, (f16*)(ws + OFF_K)}; run_gemm(F, ws + OFF_PR, ws + OFF_PB, D, 512, E); }
    SEAM(9);
    if (IN(10)) { EpiMerge E{G8, (const f16*)(ws + OFF_K), (f16*)(ws + OFF_BIG)}; run_gemm(F, ws + OFF_R, ws + OFF_ORWKV, D, D, E); if (REP_G > 1) { run_gemm(F, ws + OFF_R, ws + OFF_ORWKV, D, D, E); } }
    SEAM(10);
    if (IN(11)) { EpiResid<1> E{nullptr, nullptr, (const f16*)(ws + OFF_X1H), p.out, mod, 5, 1.0f}; run_gemm(F, ws + OFF_BIG, ws + OFF_OUTW, D, D, E); if (REP_G > 1) { run_gemm(F, ws + OFF_BIG, ws + OFF_OUTW, D, D, E); } }
    SEAM(11);
    if (IN(12)) { ln_phase<true, false, true>(F, p, 1, 6, 7); __syncthreads(); convert_ffn(F, p, 1); }
    SEAM(12);
    if (IN(13)) { EpiSwiGLU E{(f16*)(ws + OFF_BIG)}; run_gemm(F, ws + OFF_H, ws + OFF_FFNIN, 2 * DFF, D, E); if (REP_G > 1) { run_gemm(F, ws + OFF_H, ws + OFF_FFNIN, 2 * DFF, D, E); } }
    SEAM(13);
    if (IN(14)) { EpiResid<2> E{nullptr, nullptr, nullptr, p.out, mod, 8, 0.5f}; run_gemm(F, ws + OFF_BIG, ws + OFF_FFNOUT, D, DFF, E); }
    SEAM(14);
    if (IN(15)) ln_phase<true, false, false>(F, p, 2, 0, 0);
}

extern "C" void kernel_launch(void* const* d_in, const int* in_sizes, int n_in, void* d_out, int out_size, void* d_ws, size_t ws_size, hipStream_t stream) {
    static int grid = 0;
    if (grid == 0) {
        if (n_in != 28 || ws_size < WS_END) { fprintf(stderr, "kernel_launch: need 28 inputs and %zu bytes of workspace (got %d, %zu)\n", (size_t)WS_END, n_in, ws_size); grid = -1; return; }
        int dev = 0, cus = 0, per_cu = 0;
        hipGetDevice(&dev); hipDeviceGetAttribute(&cus, hipDeviceAttributeMultiprocessorCount, dev);
        if (hipFuncSetAttribute((const void*)mega_fwd, hipFuncAttributeMaxDynamicSharedMemorySize, LDS_BYTES) != hipSuccess) { fprintf(stderr, "kernel_launch: hipFuncSetAttribute failed\n"); grid = -1; return; }
        if (hipOccupancyMaxActiveBlocksPerMultiprocessor(&per_cu, (const void*)mega_fwd, 512, LDS_BYTES) != hipSuccess || per_cu < 1) { fprintf(stderr, "kernel_launch: occupancy query says %d\n", per_cu); grid = -1; return; }
        grid = cus * per_cu; if (grid > 256) grid = 256;
        fprintf(stderr, "kernel_launch: grid %d (cus %d x %d)\n", grid, cus, per_cu);
    }
    if (grid < 0) return;
    Params p{};
    for (int i = 0; i < 28; ++i) p.in[i] = (const float*)d_in[i];
    p.out = (float*)d_out; p.ws = (unsigned char*)d_ws;
#if MK_MULTI
    for (int ph = 0; ph < 16; ++ph) { p.ph_lo = ph; p.ph_hi = ph + 1; hipLaunchKernelGGL(mega_fwd, dim3(grid), dim3(512), LDS_BYTES, stream, p); }
#else
    p.ph_lo = 0; p.ph_hi = 16;
    if (hipMemsetAsync(d_ws, 0, 16384, stream) != hipSuccess) { fprintf(stderr, "kernel_launch: memset failed\n"); return; }
    void* args[] = {&p};
    hipError_t e = hipLaunchCooperativeKernel((const void*)mega_fwd, dim3(grid), dim3(512), args, LDS_BYTES, stream);
    if (e != hipSuccess) fprintf(stderr, "kernel_launch: cooperative launch failed: %s (grid %d)\n", hipGetErrorString(e), grid);
#endif
}
```

```cpp
#include <hip/hip_runtime.h>
#include <hip/hip_cooperative_groups.h>
#include <cstdio>
#include <cstdint>
namespace cg = cooperative_groups;
#ifndef MK_MULTI
#define MK_MULTI 0
#endif
namespace pg8 {
#define PG8_LAS __attribute__((address_space(3)))
typedef unsigned short bf16_t;
typedef _Float16 bf16x8 __attribute__((ext_vector_type(8)));
typedef float f32x4 __attribute__((ext_vector_type(4)));
typedef unsigned u32x4 __attribute__((ext_vector_type(4)));
constexpr int BM = 256, BK = 64, HALF = 128, HTB = HALF * BK * 2  , STAGE_BYTES = 8 * HTB, NXCD = 8, WGM = 8;

__host__ __device__ __forceinline__ int lds_byte(int r, int c) { const int st = (r >> 4) * 2 + (c >> 5), rr = r & 15, cc = c & 31, ob = rr * 64 + cc * 2; return st * 1024 + (ob ^ (((ob >> 9) & 1) << 5)); }
__host__ __device__ __forceinline__ void stage_rc(int b, int& R, int& C) { const int st = b / 1024, sb = b % 1024, swz = sb ^ (((sb >> 9) & 1) << 5); R = (st >> 1) * 16 + swz / 64; C = (st & 1) * 32 + (swz % 64) / 2; }
__host__ __device__ __forceinline__ int perm32(int rho) { const int n = rho >> 4, i = rho & 15; return 8 * (i >> 2) + 4 * n + (i & 3); }

struct Unit { int pm, pn; };
struct Gemm { const bf16_t* A; const bf16_t* Bt; int M, N, K; };

struct StaticOrder {
    int nM, nN, nwg, G, c;
    __host__ __device__ void init(int M, int N, int G_, int c_) { nM = M / BM; nN = N / BM; nwg = nM * nN; G = G_; c = c_; }
    __host__ __device__ bool next(int i, Unit& u) const {
        const long L = (long)i * G + c; if (L >= nwg) return false;
        int wgid = (int)L; { const int q = nwg / NXCD, r = nwg % NXCD, xcd = wgid % NXCD, off = wgid / NXCD; wgid = (xcd < r ? xcd * (q + 1) : r * (q + 1) + (xcd - r) * q) + off; }
        const int nig = WGM * nN, gid = wgid / nig, fm = gid * WGM, gsz = (nM - fm) < WGM ? (nM - fm) : WGM;
        u.pm = fm + ((wgid % nig) % gsz); u.pn = (wgid % nig) / gsz; return true;
    }
    __device__ __forceinline__ void a_ready(const Unit&) const {}
    __device__ __forceinline__ void done(const Unit&) const {}
};
template <class Epi, class Sched, bool STAMP = false>
__device__ __forceinline__ void gemm_phase(PG8_LAS unsigned char* lds, const Gemm g, const Sched& S, const Epi& E, unsigned long long* stamps, int tid_in) {
    const int tid = tid_in, wid = __builtin_amdgcn_readfirstlane(tid >> 6), lane = tid & 63, wr = wid >> 2, wc = wid & 3, fr = lane & 15, fq = lane >> 4;
    const int K = g.K, nt = K / BK;
    int ts_lo = 0, ts_hi = 0, nts = 0; const unsigned long long rt_entry = STAMP ? (unsigned long long)wall_clock64() : 0ull;
#define PG8_STAMP() do { if (STAMP && wid == 0 && nts < 64) { const unsigned long long _c = (unsigned long long)clock64(); \
        ts_lo = (lane == nts) ? (int)(unsigned)_c : ts_lo; ts_hi = (lane == nts) ? (int)(unsigned)(_c >> 32) : ts_hi; ++nts; } } while (0)
    PG8_STAMP();
    unsigned voffA[2], voffB[2];
#pragma unroll
    for (int i = 0; i < 2; ++i) { int R, C; stage_rc(tid * 16 + i * 8192, R, C); const int Rb = Epi::PERM ? ((R & ~31) + perm32(R & 31)) : R;
        voffA[i] = (unsigned)(R * K + C) * 2u; voffB[i] = (unsigned)(Rb * K + C) * 2u; }
    const size_t kstep = (size_t)(BK * 2);
    const size_t hstep = (size_t)HALF * K * 2;
    const size_t tstep = 2 * hstep;
    const unsigned ldsw = (unsigned)wid * 1024u;
    const int aoff = lds_byte(wr * 64 + fr, fq * 8), boff = lds_byte(wc * 32 + fr, fq * 8);
#define PG8_SA(b, h) (((b) * 2 + (h)) * HTB)
#define PG8_SB(b, h) ((4 + (b) * 2 + (h)) * HTB)
#define PG8_STAGE(bufoff, gbase, voff) do { _Pragma("unroll") for (int _i = 0; _i < 2; ++_i) \
        __builtin_amdgcn_global_load_lds((const unsigned*)((const char*)(gbase) + (voff)[_i]), (PG8_LAS unsigned*)(lds + (bufoff) + ldsw + _i * 8192), 16, 0, 0); } while (0)
#define PG8_LDA(dst, b, h) do { _Pragma("unroll") for (int m = 0; m < 4; ++m) _Pragma("unroll") for (int k = 0; k < 2; ++k) dst[m][k] = *(const PG8_LAS bf16x8*)(lds + PG8_SA(b, h) + aoff + m * 2048 + k * 1024); } while (0)
#define PG8_LDB(dst, b, h) do { _Pragma("unroll") for (int n = 0; n < 2; ++n) _Pragma("unroll") for (int k = 0; k < 2; ++k) dst[n][k] = *(const PG8_LAS bf16x8*)(lds + PG8_SB(b, h) + boff + n * 2048 + k * 1024); } while (0)
#define PG8_MMA(ai, bj, At, Bt) do { __builtin_amdgcn_s_setprio(1); _Pragma("unroll") for (int m = 0; m < 4; ++m) _Pragma("unroll") for (int n = 0; n < 2; ++n) _Pragma("unroll") for (int k = 0; k < 2; ++k) \
        acc[ai][bj][m][n] = __builtin_amdgcn_mfma_f32_16x16x32_f16(Bt[n][k], At[m][k], acc[ai][bj][m][n], 0, 0, 0); __builtin_amdgcn_s_setprio(0); } while (0)
#define PG8_WAIT_V(n) asm volatile("s_waitcnt vmcnt(" #n ")" ::: "memory")
#define PG8_WAIT_L(n) asm volatile("s_waitcnt lgkmcnt(" #n ")" ::: "memory")
#define PG8_BAR __builtin_amdgcn_s_barrier()
#define PG8_SCHED __builtin_amdgcn_sched_barrier(0)
    Unit cur, nxt; int ui = 0;
    if (!S.next(0, cur)) return;
    f32x4 acc[2][2][4][2];
#pragma unroll
    for (int a = 0; a < 2; ++a)
#pragma unroll
        for (int b = 0; b < 2; ++b)
#pragma unroll
            for (int m = 0; m < 4; ++m)
#pragma unroll
                for (int n = 0; n < 2; ++n) acc[a][b][m][n] = (f32x4){0.f, 0.f, 0.f, 0.f};
    bf16x8 At[4][2], B0[2][2], B1[2][2];
    const char* cA = (const char*)g.A + (size_t)cur.pm * tstep; const char* cB = (const char*)g.Bt + (size_t)cur.pn * tstep;
    S.a_ready(cur);
    PG8_STAGE(PG8_SB(0, 0), cB, voffB); PG8_STAGE(PG8_SA(0, 0), cA, voffA); PG8_STAGE(PG8_SB(0, 1), cB + hstep, voffB); PG8_STAGE(PG8_SA(0, 1), cA + hstep, voffA);
    if (wr == 1) PG8_BAR;
    PG8_WAIT_V(4); PG8_BAR;
    PG8_STAGE(PG8_SB(1, 0), cB + kstep, voffB); PG8_STAGE(PG8_SA(1, 0), cA + kstep, voffA); PG8_STAGE(PG8_SB(1, 1), cB + hstep + kstep, voffB);
    PG8_WAIT_V(6); PG8_BAR;
    PG8_STAMP();
    for (;;) {
        const bool has_next = S.next(ui + 1, nxt);
        const char* nA = has_next ? (const char*)g.A + (size_t)nxt.pm * tstep : cA; const char* nB = has_next ? (const char*)g.Bt + (size_t)nxt.pn * tstep : cB;
        for (int t = 0; t < nt; t += 2) {
            const bool last = (t == nt - 2);
            const char* a1 = cA + (size_t)(t + 1) * kstep;
            const char* a2 = last ? nA : cA + (size_t)(t + 2) * kstep; const char* b2 = last ? nB : cB + (size_t)(t + 2) * kstep;
            const char* a3 = a2 + kstep; const char* b3 = b2 + kstep;
            if (last && has_next) S.a_ready(nxt);
            PG8_LDB(B0, 0, 0); PG8_SCHED; PG8_LDA(At, 0, 0); PG8_STAGE(PG8_SA(1, 1), a1 + hstep, voffA);
            PG8_WAIT_L(8); PG8_BAR; PG8_WAIT_L(0); PG8_MMA(0, 0, At, B0); PG8_BAR; PG8_SCHED;
            PG8_LDB(B1, 0, 1); PG8_STAGE(PG8_SB(0, 0), b2, voffB);
            PG8_BAR; PG8_WAIT_L(0); PG8_MMA(0, 1, At, B1); PG8_BAR;
            PG8_LDA(At, 0, 1); PG8_STAGE(PG8_SA(0, 0), a2, voffA);
            PG8_BAR; PG8_WAIT_L(0); PG8_MMA(1, 0, At, B0); PG8_BAR; PG8_SCHED;
            PG8_STAGE(PG8_SB(0, 1), b2 + hstep, voffB);
            PG8_WAIT_V(6); PG8_BAR; PG8_MMA(1, 1, At, B1); PG8_BAR;
            PG8_LDB(B0, 1, 0); PG8_SCHED; PG8_LDA(At, 1, 0); PG8_STAGE(PG8_SA(0, 1), a2 + hstep, voffA);
            PG8_WAIT_L(8); PG8_BAR; PG8_WAIT_L(0); PG8_MMA(0, 0, At, B0); PG8_BAR; PG8_SCHED;
            PG8_LDB(B1, 1, 1); PG8_STAGE(PG8_SB(1, 0), b3, voffB);
            PG8_BAR; PG8_WAIT_L(0); PG8_MMA(0, 1, At, B1); PG8_BAR;
            PG8_LDA(At, 1, 1); PG8_STAGE(PG8_SA(1, 0), a3, voffA);
            PG8_BAR; PG8_WAIT_L(0); PG8_MMA(1, 0, At, B0); PG8_BAR; PG8_SCHED;
            PG8_STAGE(PG8_SB(1, 1), b3 + hstep, voffB);
            PG8_WAIT_V(6); PG8_BAR; PG8_MMA(1, 1, At, B1); PG8_BAR;
        }
        PG8_STAMP();
        if constexpr (!Epi::AFTER_DRAIN) { int fr_ = fr, fq_ = fq; asm volatile("" : "+v"(fr_), "+v"(fq_)); E(acc, cur, wr, wc, fr_, fq_); S.done(cur); }
        PG8_STAMP();
        if (!has_next) break;
#pragma unroll
        for (int a = 0; a < 2; ++a)
#pragma unroll
            for (int b = 0; b < 2; ++b)
#pragma unroll
                for (int m = 0; m < 4; ++m)
#pragma unroll
                    for (int n = 0; n < 2; ++n) acc[a][b][m][n] = (f32x4){0.f, 0.f, 0.f, 0.f};
        cur = nxt; cA = nA; cB = nB; ++ui;
    }
    PG8_WAIT_V(0);
    if (wr == 0) PG8_BAR;
    PG8_BAR;
    if constexpr (Epi::AFTER_DRAIN) { E.fused(acc, cur, wr, wc, fr, fq, lds, wid, lane); S.done(cur); }
    PG8_STAMP();
    if (STAMP && wid == 0) { stamps[lane] = lane < nts ? (((unsigned long long)(unsigned)ts_hi << 32) | (unsigned)ts_lo) : 0ull;
        if (lane == 62) stamps[62] = rt_entry; if (lane == 63) stamps[63] = (unsigned long long)wall_clock64(); }
#undef PG8_STAMP
#undef PG8_SA
#undef PG8_SB
#undef PG8_STAGE
#undef PG8_LDA
#undef PG8_LDB
#undef PG8_MMA
#undef PG8_WAIT_V
#undef PG8_WAIT_L
#undef PG8_BAR
#undef PG8_SCHED
}
}
#define LAS __attribute__((address_space(3)))
#define XB_TMO      128
#define XB_XCNT(j)  (256  + 64 * (j))
#define XB_XSUB(j)  (1280 + 64 * (j))
#define XB_XGEN(j)  (2304 + 64 * (j))
#define XB_TOP      3328
#define XB_TOPGEN   3392
#define XCD_BAR_WORDS 3456
#define XB_SPIN_CAP (1u << 18)

__device__ __forceinline__ unsigned xb_ld(unsigned* p)              { return __hip_atomic_load(p, __ATOMIC_RELAXED, __HIP_MEMORY_SCOPE_AGENT); }
__device__ __forceinline__ unsigned xb_add(unsigned* p, unsigned v) { return __hip_atomic_fetch_add(p, v, __ATOMIC_RELAXED, __HIP_MEMORY_SCOPE_AGENT); }
__device__ __forceinline__ unsigned xb_xcc_id() { return (unsigned)__builtin_amdgcn_s_getreg((3 << 11) | 20) & 0xFu; }
#define XB_SPIN(cond, bar) do { unsigned _sp = 0; while (cond) { __builtin_amdgcn_s_sleep(1); \
    if ((++_sp & 255u) == 0u) { if (xb_ld(&(bar)[XB_TMO])) break; if (_sp > XB_SPIN_CAP) { atomicAdd(&(bar)[XB_TMO], 1u); break; } } } } while (0)

struct XcdBarrier {
    unsigned* bar; unsigned x;
    volatile LAS unsigned* st;
};

__device__ __forceinline__ XcdBarrier xcd_barrier_post(unsigned* bar, volatile LAS unsigned* st, int tid) {
    XcdBarrier b; b.bar = bar; b.x = xb_xcc_id(); b.st = st;
    if (tid == 0) (void)xb_add(&bar[XB_XCNT(b.x)], 1u);
    return b;
}
__device__ __forceinline__ void xcd_barrier_complete(unsigned* bar, unsigned x, unsigned& nloc, unsigned& nx) {
    const unsigned G = gridDim.x * gridDim.y * gridDim.z;
    unsigned sum, cnt, mine, sp = 0u;
    for (;;) {
        sum = 0u; cnt = 0u; mine = 0u;
#pragma unroll
        for (unsigned j = 0; j < 16; ++j) { const unsigned c = xb_ld(&bar[XB_XCNT(j)]); sum += c; cnt += (c > 0u) ? 1u : 0u; mine = (j == x) ? c : mine; }
        if (sum == G) break;
        __builtin_amdgcn_s_sleep(1);
        if ((++sp & 255u) == 0u) { if (xb_ld(&bar[XB_TMO])) break; if (sp > XB_SPIN_CAP) { atomicAdd(&bar[XB_TMO], 1u); break; } }
    }
    nloc = mine > 0u ? mine : 1u; nx = cnt > 0u ? cnt : 1u;
}

__device__ __forceinline__ void xcd_barrier(const XcdBarrier& b, int tid) {
    asm volatile("s_waitcnt vmcnt(0)" ::: "memory");
    __syncthreads();
    if (tid == 0) {
        unsigned* bar = b.bar;
        __builtin_amdgcn_s_waitcnt(0);
        unsigned nloc = b.st[0], nx = b.st[1];
        if (nloc == 0u) { xcd_barrier_complete(bar, b.x, nloc, nx); b.st[0] = nloc; b.st[1] = nx; }
        const unsigned old = xb_add(&bar[XB_XSUB(b.x)], 1u);
        const unsigned gen = old / nloc;
        if (old + 1u == (gen + 1u) * nloc) {
            __builtin_amdgcn_fence(__ATOMIC_RELEASE, "agent");
            asm volatile("s_waitcnt vmcnt(0)" ::: "memory");
            const unsigned og = xb_add(&bar[XB_TOP], 1u);
            const unsigned tg = og / nx;
            if (og + 1u == (tg + 1u) * nx) xb_add(&bar[XB_TOPGEN], 1u);
            else XB_SPIN(xb_ld(&bar[XB_TOPGEN]) == tg, bar);
            __builtin_amdgcn_fence(__ATOMIC_ACQUIRE, "agent");
            xb_add(&bar[XB_XGEN(b.x)], 1u);
            asm volatile("s_waitcnt vmcnt(0)" ::: "memory");
        } else {
            XB_SPIN(xb_ld(&bar[XB_XGEN(b.x)]) == gen, bar);
            __builtin_amdgcn_fence(__ATOMIC_ACQUIRE, "agent");
            asm volatile("s_waitcnt vmcnt(0)" ::: "memory");
        }
    }
    __syncthreads();
}


typedef _Float16 f16;
typedef _Float16 h8 __attribute__((ext_vector_type(8)));
typedef _Float16 h4 __attribute__((ext_vector_type(4)));
typedef _Float16 h2 __attribute__((ext_vector_type(2)));
typedef float f32x4 __attribute__((ext_vector_type(4)));
typedef unsigned u32x2 __attribute__((ext_vector_type(2)));
using pg8::Unit;

constexpr int D = 1024, NTOK = 12288, NCTX = 4096, DFF = 2816, PROJ_LD = 3968, NMIX = 6144, NMIX_REAL = 6016, LORA_K = 384, LORA_N = 5120;
constexpr float ALPHA = 1.189207115002721f;
constexpr size_t MiB = 1048576;
constexpr size_t OFF_MOD = 16384, OFF_INV = 131072, OFF_BC = 917504;
constexpr size_t OFF_LORA = 2 * MiB, OFF_ORWKV = OFF_LORA + 3932160, OFF_OUTW = OFF_ORWKV + 2 * MiB, OFF_PB = OFF_OUTW + 2 * MiB;
constexpr size_t OFF_FFNIN = OFF_PB + 1 * MiB, OFF_FFNOUT = OFF_FFNIN + 11 * MiB, OFF_MIXW = OFF_FFNOUT + 5767168;
constexpr size_t OFF_Y = OFF_FFNIN;
constexpr size_t OFF_X1H = OFF_MIXW + 12 * MiB;
constexpr size_t OFF_H = OFF_X1H + 24 * MiB, OFF_LA = OFF_H, OFF_PR = OFF_H + 9 * MiB;
constexpr size_t OFF_BIG = OFF_H + 24 * MiB;
constexpr size_t OFF_W = OFF_BIG, OFF_A = OFF_BIG + 48 * MiB;
constexpr size_t OFF_R = OFF_BIG + 96 * MiB, OFF_K = OFF_R + 24 * MiB, OFF_V = OFF_K + 24 * MiB;
constexpr size_t WS_END = OFF_V + 24 * MiB;
static_assert(OFF_X1H == 41156608 && WS_END <= 268435456, "workspace map");
constexpr int LDS_TAB = 131072, LDS_XB = 131072 + 240, LDS_BYTES = 131072 + 256;

struct Params { const float* in[28]; float* out; unsigned char* ws; int ph_lo, ph_hi; };

__device__ __forceinline__ float sigmoidf_(float x) { return __builtin_amdgcn_rcpf(1.0f + __expf(-x)); }
__device__ __forceinline__ float siluf_(float x) { return x * __builtin_amdgcn_rcpf(1.0f + __expf(-x)); }
__device__ __forceinline__ f32x4 h4_to_f4(h4 v) { return (f32x4){(float)v[0], (float)v[1], (float)v[2], (float)v[3]}; }
__device__ __forceinline__ h4 f4_to_h4(f32x4 v) { return (h4){(f16)v[0], (f16)v[1], (f16)v[2], (f16)v[3]}; }
__device__ __forceinline__ h8 f8_to_h8(f32x4 a, f32x4 b) { return (h8){(f16)a[0], (f16)a[1], (f16)a[2], (f16)a[3], (f16)b[0], (f16)b[1], (f16)b[2], (f16)b[3]}; }
__device__ __forceinline__ float xor16_sum(float v) { v += __shfl_xor(v, 1); v += __shfl_xor(v, 2); v += __shfl_xor(v, 4); v += __shfl_xor(v, 8); return v; }
__device__ __forceinline__ float wave_sum(float v) {
#pragma unroll
    for (int o = 1; o < 64; o <<= 1) v += __shfl_xor(v, o);
    return v;
}
template <int CTRL> __device__ __forceinline__ float dpp_add(float x) {
    return x + __int_as_float(__builtin_amdgcn_update_dpp(0, __float_as_int(x), CTRL, 0xf, 0xf, false));
}
__device__ __forceinline__ float row16_sum(float x) {
    x = dpp_add<0xB1>(x);
    x = dpp_add<0x4E>(x);
    x = dpp_add<0x141>(x);
    x = dpp_add<0x140>(x);
    return x;
}
__device__ __forceinline__ int mod_index(int row) { return row < NCTX ? 0 : (row < 2 * NCTX ? 1 : 2); }

struct EpiSwiGLU {
    static constexpr bool PERM = true, AFTER_DRAIN = false;
    f16* O;
    __device__ __forceinline__ void operator()(const f32x4 (&acc)[2][2][4][2], const Unit& u, int wr, int wc, int fr, int fq) const {
        const int row0 = u.pm * 256 + wr * 64 + fr, col0 = u.pn * 128 + wc * 32 + 8 * fq;
#pragma unroll
        for (int ai = 0; ai < 2; ++ai)
#pragma unroll
            for (int m = 0; m < 4; ++m) {
                f32x4 o0, o1;
#pragma unroll
                for (int j = 0; j < 4; ++j) { o0[j] = siluf_(acc[ai][0][m][0][j]) * acc[ai][1][m][0][j]; o1[j] = siluf_(acc[ai][0][m][1][j]) * acc[ai][1][m][1][j]; }
                *(h8*)(O + (size_t)(row0 + ai * 128 + m * 16) * DFF + col0) = f8_to_h8(o0, o1);
            }
    }
};
template <int SRC  > struct EpiResid {
    static constexpr bool PERM = false, AFTER_DRAIN = false;
    const float* xa; const float* xb; const f16* xh; float* out; const float* mod; int mg; float coef;
    __device__ __forceinline__ void operator()(const f32x4 (&acc)[2][2][4][2], const Unit& u, int wr, int wc, int fr, int fq) const {
        const int midx = u.pm < 16 ? 0 : (u.pm < 32 ? 1 : 2);
        const float* mrow = mod + (midx * 9 + mg) * D;
        const int row0 = u.pm * 256 + wr * 64 + fr, col0 = u.pn * 256 + wc * 32 + 4 * fq;
#pragma unroll
        for (int ai = 0; ai < 2; ++ai)
#pragma unroll
            for (int m = 0; m < 4; ++m) {
                const int row = row0 + ai * 128 + m * 16;
#pragma unroll
                for (int bj = 0; bj < 2; ++bj)
#pragma unroll
                    for (int n = 0; n < 2; ++n) {
                        const int c = col0 + bj * 128 + n * 16; f32x4 x;
                        const f32x4 mv = *(const f32x4*)(mrow + c) * coef;
                        if (SRC == 0) x = *(const f32x4*)((row < NCTX ? xa + (size_t)row * D : xb + (size_t)(row - NCTX) * D) + c);
                        else if (SRC == 1) x = h4_to_f4(*(const h4*)(xh + (size_t)row * D + c));
                        else x = *(const f32x4*)(out + (size_t)row * D + c);
                        *(f32x4*)(out + (size_t)row * D + c) = x * ALPHA + mv * acc[ai][bj][m][n];
                    }
                asm volatile("" ::: "memory");
            }
    }
};
__device__ __forceinline__ unsigned pack_u8x4(f32x4 v) {
    const unsigned a = (unsigned)(v[0] * 255.0f + 0.5f), b = (unsigned)(v[1] * 255.0f + 0.5f), c = (unsigned)(v[2] * 255.0f + 0.5f), d = (unsigned)(v[3] * 255.0f + 0.5f);
    return a | (b << 8) | (c << 16) | (d << 24);
}
__device__ __forceinline__ f32x4 unpack_u8x4(unsigned w) {
    return (f32x4){(float)(w & 255u), (float)((w >> 8) & 255u), (float)((w >> 16) & 255u), (float)(w >> 24)} * (1.0f / 255.0f);
}
struct EpiMixProj {
    static constexpr bool PERM = true, AFTER_DRAIN = false;
    f16* PS; unsigned char* G8;
    __device__ __forceinline__ void operator()(const f32x4 (&acc)[2][2][4][2], const Unit& u, int wr, int wc, int fr, int fq) const {
        const int row0 = u.pm * 256 + wr * 64 + fr;
#pragma unroll
        for (int bj = 0; bj < 2; ++bj) {
            const int gc0 = u.pn * 256 + bj * 128;
            if (gc0 >= NMIX_REAL) continue;
            const int col = gc0 + wc * 32 + 8 * fq;
#pragma unroll
            for (int ai = 0; ai < 2; ++ai)
#pragma unroll
                for (int m = 0; m < 4; ++m) {
                    const int row = row0 + ai * 128 + m * 16;
                    const f32x4 v0 = acc[ai][bj][m][0], v1 = acc[ai][bj][m][1];
                    if (gc0 < PROJ_LD) *(h8*)(PS + (size_t)row * PROJ_LD + col) = f8_to_h8(v0, v1);
                    else {
                        f32x4 s0, s1;
#pragma unroll
                        for (int j = 0; j < 4; ++j) { s0[j] = sigmoidf_(v0[j]); s1[j] = sigmoidf_(v1[j]); }
                        u32x2 w; w.x = pack_u8x4(s0); w.y = pack_u8x4(s1);
                        *(u32x2*)(G8 + (size_t)row * 2048 + (col - PROJ_LD)) = w;
                    }
                }
        }
    }
};
struct EpiLora {
    static constexpr bool PERM = true, AFTER_DRAIN = false;
    f16* W; f16* A; f16* G; const float* w0; const float* a0;
    __device__ __forceinline__ void operator()(const f32x4 (&acc)[2][2][4][2], const Unit& u, int wr, int wc, int fr, int fq) const {
        const int sec = u.pn >> 2, row0 = u.pm * 256 + wr * 64 + fr;
        f16* dst = sec < 2 ? W + (size_t)sec * NTOK * D : (sec < 4 ? A + (size_t)(sec - 2) * NTOK * D : G);
        const float* bias = sec < 2 ? w0 + sec * D : a0 + (sec & 1) * D;
        const float bsc = sec < 4 ? 1.0f : 0.0f;
#pragma unroll
        for (int bj = 0; bj < 2; ++bj) {
            const int c = (u.pn & 3) * 256 + bj * 128 + wc * 32 + 8 * fq;
            const f32x4 b0 = *(const f32x4*)(bias + c) * bsc, b1 = *(const f32x4*)(bias + c + 4) * bsc;
#pragma unroll
            for (int ai = 0; ai < 2; ++ai)
#pragma unroll
                for (int m = 0; m < 4; ++m) {
                    const int row = row0 + ai * 128 + m * 16;
                    f32x4 v0 = acc[ai][bj][m][0] + b0, v1 = acc[ai][bj][m][1] + b1;
#pragma unroll
                    for (int j = 0; j < 4; ++j) {
                        const float s0 = sigmoidf_(v0[j]), s1 = sigmoidf_(v1[j]);
                        const float e0 = __expf(-0.6065306597126334f * s0), e1 = __expf(-0.6065306597126334f * s1);
                        v0[j] = sec < 2 ? e0 : (sec < 4 ? s0 : v0[j]); v1[j] = sec < 2 ? e1 : (sec < 4 ? s1 : v1[j]);
                    }
                    *(h8*)(dst + (size_t)row * D + c) = f8_to_h8(v0, v1);
                    __builtin_amdgcn_sched_barrier(0);
                }
        }
    }
};
struct EpiPool {
    static constexpr bool PERM = true, AFTER_DRAIN = false;
    const unsigned char* G8; f16* GBYB;
    __device__ __forceinline__ void operator()(const f32x4 (&acc)[2][2][4][2], const Unit& u, int wr, int wc, int fr, int fq) const {
        const int row0 = u.pm * 256 + wr * 64 + fr;
#pragma unroll
        for (int bj = 0; bj < 2; ++bj) {
            const int c = u.pn * 256 + bj * 128 + wc * 32 + 8 * fq;
#pragma unroll
            for (int ai = 0; ai < 2; ++ai)
#pragma unroll
                for (int m = 0; m < 4; ++m) {
                    const int row = row0 + ai * 128 + m * 16;
                    const u32x2 g = *(const u32x2*)(G8 + (size_t)row * 2048 + 1024 + c);
                    *(h8*)(GBYB + (size_t)row * D + c) = f8_to_h8(unpack_u8x4(g.x) * acc[ai][bj][m][0], unpack_u8x4(g.y) * acc[ai][bj][m][1]);
                }
        }
    }
};
struct EpiMerge {
    static constexpr bool PERM = true, AFTER_DRAIN = false;
    const unsigned char* G8; const f16* GBYB; f16* MG;
    __device__ __forceinline__ void operator()(const f32x4 (&acc)[2][2][4][2], const Unit& u, int wr, int wc, int fr, int fq) const {
        const int row0 = u.pm * 256 + wr * 64 + fr;
#pragma unroll
        for (int bj = 0; bj < 2; ++bj) {
            const int c = u.pn * 256 + bj * 128 + wc * 32 + 8 * fq;
#pragma unroll
            for (int ai = 0; ai < 2; ++ai)
#pragma unroll
                for (int m = 0; m < 4; ++m) {
                    const int row = row0 + ai * 128 + m * 16;
                    const u32x2 g = *(const u32x2*)(G8 + (size_t)row * 2048 + c);
                    const h8 yb = *(const h8*)(GBYB + (size_t)row * D + c);
                    f32x4 o0 = unpack_u8x4(g.x) * acc[ai][bj][m][0], o1 = unpack_u8x4(g.y) * acc[ai][bj][m][1];
#pragma unroll
                    for (int j = 0; j < 4; ++j) { o0[j] += (float)yb[j]; o1[j] += (float)yb[4 + j]; }
                    *(h8*)(MG + (size_t)row * D + c) = f8_to_h8(o0, o1);
                }
        }
    }
};

struct Frame { LAS unsigned char* lds; int tid, lane, wave, G, bid, gw, NGW, epoch; };
#define LDS_WAIT() asm volatile("s_waitcnt lgkmcnt(0)" ::: "memory")
__device__ __forceinline__ const float* inp(const Frame& F, int i) {
    const unsigned long long v = *(const LAS unsigned long long*)(F.lds + LDS_TAB + 8 * i);
    const unsigned lo = __builtin_amdgcn_readfirstlane((unsigned)v), hi = __builtin_amdgcn_readfirstlane((unsigned)(v >> 32));
    return (const float*)(((unsigned long long)hi << 32) | lo);
}

template <class Epi> __device__ __forceinline__ void run_gemm(const Frame& F, const void* A, const void* Bt, int N, int K, const Epi& E) {
    asm volatile("" : "+s"(K));
    pg8::Gemm g{(const pg8::bf16_t*)A, (const pg8::bf16_t*)Bt, NTOK, N, K};
    pg8::StaticOrder S; S.init(NTOK, N, F.G, F.bid);
    pg8::gemm_phase<Epi, pg8::StaticOrder>(F.lds, g, S, E, nullptr, F.tid);
}

__device__ __forceinline__ void tr_item(const float* W, int ldw, int srccol0, int k0, f16* WT, int ldk, int dstrow0, LAS float* scr, int lane) {
#pragma unroll
    for (int i = 0; i < 32; ++i) { const int kk = 2 * i + (lane >> 5); scr[kk * 33 + (lane & 31)] = W[(size_t)(k0 + kk) * ldw + srccol0 + (lane & 31)]; }
    LDS_WAIT();
    const int c = lane & 7;
#pragma unroll
    for (int j = 0; j < 4; ++j) { const int n = (lane >> 3) + 8 * j; const LAS float* s = scr + (8 * c) * 33 + n;
        h8 o = (h8){(f16)s[0], (f16)s[33], (f16)s[66], (f16)s[99], (f16)s[132], (f16)s[165], (f16)s[198], (f16)s[231]};
        *(h8*)(WT + (size_t)(dstrow0 + n) * ldk + k0 + 8 * c) = o; }
    LDS_WAIT();
}
__device__ __forceinline__ int ffn_in_srccol(int n0) { const int u = n0 >> 8, i = n0 & 255; return i < 128 ? 128 * u + i : DFF + 128 * u + (i - 128); }
__device__ __forceinline__ void convert_ffn(const Frame& F, const Params& p, int l) {
    LAS float* scr = (LAS float*)(F.lds + F.wave * 8448);
    const float* fin = inp(F, 9) + (size_t)l * D * 2 * DFF; const float* fout = inp(F, 10) + (size_t)l * DFF * D;
    f16* FI = (f16*)(p.ws + OFF_FFNIN); f16* FO = (f16*)(p.ws + OFF_FFNOUT);
    constexpr int I1 = 16 * 176, I2 = 44 * 32;
    for (int it = F.gw; it < I1 + I2; it += F.NGW) {
        if (it < I1) { const int nb = it % 176, kb = it / 176; tr_item(fin, 2 * DFF, ffn_in_srccol(32 * nb), 64 * kb, FI, D, 32 * nb, scr, F.lane); }
        else { const int r = it - I1, nb = r % 32, kb = r / 32; tr_item(fout, D, 32 * nb, 64 * kb, FO, DFF, 32 * nb, scr, F.lane); }
    }
}

__device__ __forceinline__ void p0_prologue(const Frame& F, const Params& p) {
    for (int it = F.bid; it < 144; it += F.G) {
        const int l4 = F.tid & 15, kg = F.tid >> 4;
        const float* wm = inp(F, 5); const float* cc = inp(F, 2); const float* cx = inp(F, 4);
        f32x4 a0 = (f32x4){0.f, 0.f, 0.f, 0.f}, a1 = a0, a2 = a0;
#pragma unroll 4
        for (int kk = 0; kk < 32; ++kk) { const int k = 32 * kg + kk;
            const f32x4 w = *(const f32x4*)(wm + (size_t)k * 9216 + 64 * it + 4 * l4);
            a0 += w * siluf_(cx[k]); a1 += w * siluf_(cc[k]); a2 += w * siluf_(cc[D + k]); }
        LAS float* red = (LAS float*)F.lds;
        *(LAS f32x4*)(red + (kg * 3 + 0) * 64 + 4 * l4) = a0; *(LAS f32x4*)(red + (kg * 3 + 1) * 64 + 4 * l4) = a1; *(LAS f32x4*)(red + (kg * 3 + 2) * 64 + 4 * l4) = a2;
        __syncthreads();
        if (F.tid < 192) { const int i = F.tid >> 6, c = F.tid & 63; float s = 0.f;
            for (int g = 0; g < 32; ++g) s += red[(g * 3 + i) * 64 + c];
            ((float*)(p.ws + OFF_MOD))[i * 9216 + 64 * it + c] = s + inp(F, 6)[64 * it + c]; }
        __syncthreads();
    }
    convert_ffn(F, p, 0);
    {
        LAS float* scr = (LAS float*)(F.lds + F.wave * 8448);
        f16* MX = (f16*)(p.ws + OFF_MIXW); f16* WO = (f16*)(p.ws + OFF_ORWKV); f16* WU = (f16*)(p.ws + OFF_OUTW);
        constexpr int I1 = 16 * 188, I2 = 16 * 32;
        for (int it = F.gw; it < I1 + 2 * I2; it += F.NGW) {
            if (it < I1) { const int nb = it % 188, kb = it / 188; tr_item(inp(F, 11), NMIX_REAL, 32 * nb, 64 * kb, MX, D, 32 * nb, scr, F.lane); }
            else if (it < I1 + I2) { const int r = it - I1, nb = r % 32, kb = r / 32; tr_item(inp(F, 23), D, 32 * nb, 64 * kb, WO, D, 32 * nb, scr, F.lane); }
            else { const int r = it - I1 - I2, nb = r % 32, kb = r / 32; tr_item(inp(F, 27), D, 32 * nb, 64 * kb, WU, D, 32 * nb, scr, F.lane); }
        }
        const int gt = F.bid * 512 + F.tid, NT = F.G * 512;
        for (int i = gt; i < 128 * D / 8; i += NT) *(h8*)(MX + (size_t)NMIX_REAL * D + (size_t)i * 8) = (h8){0, 0, 0, 0, 0, 0, 0, 0};
        f16* LW = (f16*)(p.ws + OFF_LORA);
        for (int i = gt; i < LORA_N * 48; i += NT) {
            const int n = i % LORA_N, k8 = (i / LORA_N) * 8, sec = n >> 10, c = n & 1023;
            const float* src; int koff, klen;
            if (sec == 0) { src = inp(F, 14); koff = 0; klen = 64; } else if (sec == 1) { src = inp(F, 14) + 64 * D; koff = 64; klen = 64; }
            else if (sec == 2) { src = inp(F, 16); koff = 128; klen = 64; } else if (sec == 3) { src = inp(F, 16) + 64 * D; koff = 192; klen = 64; }
            else { src = inp(F, 17); koff = 256; klen = 128; }
            h8 o = (h8){0, 0, 0, 0, 0, 0, 0, 0};
            if (k8 >= koff && k8 < koff + klen) {
#pragma unroll
                for (int e = 0; e < 8; ++e) o[e] = (f16)src[(size_t)(k8 - koff + e) * D + c];
            }
            *(h8*)(LW + (size_t)n * LORA_K + k8) = o;
        }
        f16* PBW = (f16*)(p.ws + OFF_PB);
        for (int i = gt; i < 1024 * 64; i += NT) {
            const int n = i & 1023, k0 = (i >> 10) * 8, g = k0 >> 7, c0 = k0 & 127;
            const float* wp = inp(F, 24) + (size_t)g * 128 * 128 + (size_t)c0 * 128; const float* ps = inp(F, 25) + g * 128; const float* wo = inp(F, 26) + (size_t)g * 128 * D + n;
            float a[8] = {0.f, 0.f, 0.f, 0.f, 0.f, 0.f, 0.f, 0.f};
#pragma unroll 8
            for (int d = 0; d < 128; ++d) { const float t = ps[d] * wo[(size_t)d * D];
#pragma unroll
                for (int e = 0; e < 8; ++e) a[e] += wp[e * 128 + d] * t; }
            *(h8*)(PBW + (size_t)n * 512 + k0) = (h8){(f16)a[0], (f16)a[1], (f16)a[2], (f16)a[3], (f16)a[4], (f16)a[5], (f16)a[6], (f16)a[7]};
        }
    }
}

__device__ __forceinline__ void p1_h1(const Frame& F, const Params& p) {
    const float* mod = (const float*)(p.ws + OFF_MOD); f16* H = (f16*)(p.ws + OFF_H);
    for (int row = F.gw; row < NTOK; row += F.NGW) {
        const float* x = row < NCTX ? inp(F, 0) + (size_t)row * D : inp(F, 1) + (size_t)(row - NCTX) * D;
        const float* m0 = mod + (mod_index(row) * 9 + 0) * D; const float* m1 = m0 + D;
#pragma unroll
        for (int j = 0; j < 4; ++j) { const int c = 4 * F.lane + 256 * j;
            const f32x4 v = *(const f32x4*)(x + c), a = *(const f32x4*)(m0 + c), b = *(const f32x4*)(m1 + c);
            *(h4*)(H + (size_t)row * D + c) = f4_to_h4(v * (b + 1.0f) + a); }
    }
}

template <bool WX32, bool WXH, bool WH> __device__ __forceinline__ void ln_phase(const Frame& F, const Params& p, int lni, int mh, int ms) {
    const float* mod = (const float*)(p.ws + OFF_MOD); f16* H = (f16*)(p.ws + OFF_H); f16* XH = (f16*)(p.ws + OFF_X1H);
    const float* g = inp(F, 7) + lni * D; const float* b = inp(F, 8) + lni * D;
    for (int row = F.gw; row < NTOK; row += F.NGW) {
        float* z = p.out + (size_t)row * D;
        f32x4 v[4]; float s = 0.f;
#pragma unroll
        for (int j = 0; j < 4; ++j) { v[j] = *(const f32x4*)(z + 4 * F.lane + 256 * j); s += (v[j][0] + v[j][1]) + (v[j][2] + v[j][3]); }
        const float mean = wave_sum(s) * (1.0f / D); float q = 0.f;
#pragma unroll
        for (int j = 0; j < 4; ++j) { v[j] = v[j] - mean; q += (v[j][0] * v[j][0] + v[j][1] * v[j][1]) + (v[j][2] * v[j][2] + v[j][3] * v[j][3]); }
        const float rstd = 1.0f / sqrtf(wave_sum(q) * (1.0f / D) + 1e-5f);
        const float* mrow = mod + (size_t)mod_index(row) * 9 * D;
#pragma unroll
        for (int j = 0; j < 4; ++j) { const int c = 4 * F.lane + 256 * j;
            const f32x4 x = v[j] * rstd * *(const f32x4*)(g + c) + *(const f32x4*)(b + c);
            if (WX32) *(f32x4*)(z + c) = x;
            if (WXH) *(h4*)(XH + (size_t)row * D + c) = f4_to_h4(x);
            if (WH) *(h4*)(H + (size_t)row * D + c) = f4_to_h4(x * (*(const f32x4*)(mrow + ms * D + c) + 1.0f) + *(const f32x4*)(mrow + mh * D + c)); }
    }
}

struct TokPos { int row, pos, T, lat; };
__device__ __forceinline__ f32x4 shift_mix4(const f16* PS, const float* mu, const TokPos& t, int col) {
    const f16* own = PS + (size_t)t.row * PROJ_LD + col;
    const f32x4 o = h4_to_f4(*(const h4*)own);
    f32x4 sh;
    if (!t.lat) {
        const f32x4 pv = t.pos > 0 ? h4_to_f4(*(const h4*)(own - PROJ_LD)) : (f32x4){0.f, 0.f, 0.f, 0.f};
        const f32x4 nx = t.pos < t.T - 1 ? h4_to_f4(*(const h4*)(own + PROJ_LD)) : (f32x4){0.f, 0.f, 0.f, 0.f};
        sh = (f32x4){pv[0], nx[1], pv[2], nx[3]};
    } else {
        const int gr = t.pos >> 6, gc = t.pos & 63;
        sh[0] = gc > 0 ? (float)own[-PROJ_LD + 0] : 0.f;
        sh[1] = gc < 63 ? (float)own[PROJ_LD + 1] : 0.f;
        sh[2] = gr > 0 ? (float)own[-64 * PROJ_LD + 2] : 0.f;
        sh[3] = gr < 63 ? (float)own[64 * PROJ_LD + 3] : 0.f;
    }
    const f32x4 m = *(const f32x4*)(mu + col);
    return o + m * (sh - o);
}
__device__ __forceinline__ void p6_prep(const Frame& F, const Params& p) {
    const f16* PS = (const f16*)(p.ws + OFF_BIG);
    f16* R = (f16*)(p.ws + OFF_R); f16* K = (f16*)(p.ws + OFF_K); f16* V = (f16*)(p.ws + OFF_V);
    f16* LA = (f16*)(p.ws + OFF_LA); f16* PR = (f16*)(p.ws + OFF_PR);
    float* INV = (float*)(p.ws + OFF_INV); float* BC = (float*)(p.ws + OFF_BC);
    const float* mu = inp(F, 12); const float* k_k = inp(F, 18); const float* r_k = inp(F, 20);
    { const int gt = F.bid * 512 + F.tid, NT = F.G * 512; f32x4* Y4 = (f32x4*)(p.ws + OFF_Y);
      for (int i = gt; i < NTOK * D * 2 / 16; i += NT) Y4[i] = (f32x4){0.f, 0.f, 0.f, 0.f}; }
    for (int row = F.gw; row < NTOK; row += F.NGW) {
        TokPos t; t.row = row;
        if (row < NCTX) { t.lat = 0; t.pos = row & 255; t.T = 256; } else { t.lat = 1; t.pos = (row - NCTX) & 4095; t.T = 4096; }
        const int lane = F.lane;
#pragma unroll
        for (int jj = 0; jj < 4; ++jj) {
            const int c = 4 * lane + 256 * jj;
            const f32x4 r = shift_mix4(PS, mu, t, c), k = shift_mix4(PS, mu, t, D + c), v = shift_mix4(PS, mu, t, 2 * D + c);
            *(h4*)(R + (size_t)row * D + c) = f4_to_h4(r); *(h4*)(K + (size_t)row * D + c) = f4_to_h4(k); *(h4*)(V + (size_t)row * D + c) = f4_to_h4(v);
            const f32x4 kk = k * *(const f32x4*)(k_k + c), rk = r * k * *(const f32x4*)(r_k + c);
            const float n2 = xor16_sum((kk[0] * kk[0] + kk[1] * kk[1]) + (kk[2] * kk[2] + kk[3] * kk[3]));
            const float bc = xor16_sum((rk[0] + rk[1]) + (rk[2] + rk[3]));
            if ((lane & 15) == 0) { const int h = 4 * jj + (lane >> 4); INV[row * 16 + h] = 1.0f / fmaxf(sqrtf(n2), 1e-12f); BC[row * 16 + h] = bc; }
        }
        {
            f32x4 x = shift_mix4(PS, mu, t, 3 * D + 4 * lane);
            if (lane < 32) {
#pragma unroll
                for (int j = 0; j < 4; ++j) x[j] = 1.0f - 2.0f * __builtin_amdgcn_rcpf(__expf(2.0f * x[j]) + 1.0f);
            }
            *(h4*)(LA + (size_t)row * LORA_K + 4 * lane) = f4_to_h4(x);
        }
        if (lane < 32) {
            f32x4 x = shift_mix4(PS, mu, t, 3 * D + 256 + 4 * lane);
#pragma unroll
            for (int j = 0; j < 4; ++j) x[j] = sigmoidf_(x[j]);
            *(h4*)(LA + (size_t)row * LORA_K + 256 + 4 * lane) = f4_to_h4(x);
        }
        {
            const int half = 1 << (lane >> 4);
            const int lo = max(t.pos - half, 0), hi = min(t.pos + half, t.T);
            const f16* base = PS + (size_t)(row - t.pos) * PROJ_LD + 3456 + 8 * lane;
            float s[8] = {0.f, 0.f, 0.f, 0.f, 0.f, 0.f, 0.f, 0.f};
#pragma unroll
            for (int qq = 0; qq < 16; ++qq) { const int q = lo + qq;
                if (q < hi) { const h8 x = *(const h8*)(base + (size_t)q * PROJ_LD);
#pragma unroll
                    for (int e = 0; e < 8; ++e) s[e] += (float)x[e]; } }
            const h8 self = *(const h8*)(base + (size_t)t.pos * PROJ_LD);
            const float inv = 1.0f / (float)(hi - lo);
            h8 o;
#pragma unroll
            for (int e = 0; e < 8; ++e) o[e] = (f16)(s[e] * inv - (float)self[e]);
            *(h8*)(PR + (size_t)row * 512 + 8 * lane) = o;
        }
    }
}

__device__ __forceinline__ int scan_desc(int grp, int vb, int it) {
    int dsc;
    if (grp == 0) { const int chain = vb >> 2; dsc = ((it >= 0 && it < 256) ? 1 : 0) | ((chain >> 5) << 1) | ((chain & 15) << 2) | ((vb & 3) << 6) | (((chain >> 4) & 1) << 8) | ((it & 255) << 12) | (1 << 20); }
    else { const int task = vb * 8 + ((it >> 4) & 7), chain = task >> 2; dsc = ((it >= 0 && it < 128) ? 1 : 0) | ((chain >> 8) << 1) | ((chain & 15) << 2) | ((task & 3) << 6) | (((chain >> 4) & 15) << 8) | ((it & 15) << 12); }
    dsc = __builtin_amdgcn_readfirstlane(dsc);
    asm volatile("" : "+s"(dsc));
    return dsc;
}
#define SD_ACT(x) ((x) & 1)
#define SD_D(x) (((x) >> 1) & 1)
#define SD_H(x) (((x) >> 2) & 15)
#define SD_RG(x) (((x) >> 6) & 3)
#define SD_SIDX(x) (((x) >> 8) & 15)
#define SD_CHUNK(x) (((x) >> 12) & 255)
#define SD_LAT(x) (((x) >> 20) & 1)
__device__ __forceinline__ int scan_row(int dsc, int s_) {
    const int lat = SD_LAT(dsc), T = lat ? 4096 : 256, seqbase = lat ? NCTX + SD_SIDX(dsc) * 4096 : SD_SIDX(dsc) * 256, tl = SD_CHUNK(dsc) * 16 + s_;
    return seqbase + (SD_D(dsc) ? T - 1 - tl : tl);
}
typedef float f32x2 __attribute__((ext_vector_type(2)));
__device__ __forceinline__ void p8_scan(const Frame& F, const Params& p) {
    const int grp = F.wave >> 2, gtid = F.tid & 255, gw4 = F.wave & 3, lane = F.lane, ks = lane & 15, rl = gw4 * 4 + (lane >> 4);
    LAS float* gb = (LAS float*)(F.lds + grp * 53248);
    const int s_st = gtid >> 4, kq = gtid & 15;
    unsigned char* ws = p.ws;
    for (int vb = F.bid; vb < 256; vb += F.G) {
        f32x4 S0 = (f32x4){0.f, 0.f, 0.f, 0.f};
        if (grp == 0) { const int t0 = scan_desc(0, vb, 0);
            S0 = *(const f32x4*)(inp(F, 3) + ((size_t)((SD_SIDX(t0) * 2 + SD_D(t0)) * 16 + SD_H(t0))) * 4096 + (SD_RG(t0) * 16 + rl) * 64 + 4 * ks); }
        { float one_; asm volatile("v_mov_b32 %0, 1.0" : "=v"(one_)); S0 = S0 * one_; }
        f32x2 Sa = (f32x2){0.f, 0.f}, Sb = Sa;
        h4 q_r = (h4){0, 0, 0, 0}, q_k = q_r, q_v = q_r, q_w = q_r, q_a = q_r; float q_inv = 0.f; f32x4 q_kk = (f32x4){0.f, 0.f, 0.f, 0.f}, q_ka = q_kk;
        for (int it = -1; it <= 256; ++it) {
            const int tn = scan_desc(grp, vb, it + 1);
            if (SD_ACT(tn)) {
                const int row = scan_row(tn, s_st), col = SD_H(tn) * 64 + 4 * kq; const size_t o = ((size_t)row * D + col) * 2;
                q_r = *(const h4*)(ws + OFF_R + o); q_k = *(const h4*)(ws + OFF_K + o); q_v = *(const h4*)(ws + OFF_V + o);
                const size_t od = o + (size_t)SD_D(tn) * NTOK * D * 2;
                q_w = *(const h4*)(ws + OFF_W + od); q_a = *(const h4*)(ws + OFF_A + od);
                q_inv = ((const float*)(ws + OFF_INV))[row * 16 + SD_H(tn)]; q_kk = *(const f32x4*)(inp(F, 18) + col); q_ka = *(const f32x4*)(inp(F, 19) + col);
            }
            const int tp = scan_desc(grp, vb, it - 1);
            if (SD_ACT(tp) && gtid < 128) {
                const LAS float* yb = gb + 12288 + ((it - 1) & 1) * 256;
                const int s_ = gtid >> 3, pr = gtid & 7, row = scan_row(tp, s_);
                const h2 val = (h2){(f16)yb[s_ * 16 + 2 * pr], (f16)yb[s_ * 16 + 2 * pr + 1]};
                __builtin_amdgcn_global_atomic_fadd_v2f16((__attribute__((address_space(1))) h2*)(ws + OFF_Y + ((size_t)row * D + SD_H(tp) * 64 + SD_RG(tp) * 16 + 2 * pr) * 2), val);
            }
            const int t = scan_desc(grp, vb, it);
            if (SD_ACT(t)) {
                const LAS float* sb = gb + (it & 1) * 6144;
                const int vrow = SD_RG(t) * 16 + rl;
                if (SD_CHUNK(t) == 0) { const float z = SD_LAT(t) ? 1.0f : 0.0f; Sa = (f32x2){S0[0], S0[1]} * z; Sb = (f32x2){S0[2], S0[3]} * z; }
                float yacc = 0.f, qp = 0.f;
#pragma unroll
                for (int s_ = 0; s_ < 16; ++s_) {
                    const f32x4 w = *(const LAS f32x4*)(sb + s_ * 64 + 4 * ks), nkka = *(const LAS f32x4*)(sb + 1024 + s_ * 64 + 4 * ks), kd = *(const LAS f32x4*)(sb + 2048 + s_ * 64 + 4 * ks);
                    const f32x4 r = *(const LAS f32x4*)(sb + 3072 + s_ * 64 + 4 * ks), kk = *(const LAS f32x4*)(sb + 4096 + s_ * 64 + 4 * ks);
                    const float vv = sb[5120 + s_ * 64 + vrow];
                    f32x2 tt = Sa * (f32x2){kk[0], kk[1]}; tt = Sb * (f32x2){kk[2], kk[3]} + tt;
                    float pp = tt[0] + tt[1];
                    pp = dpp_add<0xB1>(pp); qp = dpp_add<0xB1>(qp); pp = dpp_add<0x4E>(pp); qp = dpp_add<0x4E>(qp);
                    pp = dpp_add<0x141>(pp); qp = dpp_add<0x141>(qp); pp = dpp_add<0x140>(pp); qp = dpp_add<0x140>(qp);
                    yacc = (ks == s_ - 1) ? qp : yacc;
                    const f32x2 vv2 = (f32x2){vv, vv}, sa2 = (f32x2){pp, pp};
                    f32x2 Ta = Sa * (f32x2){w[0], w[1]}, Tb = Sb * (f32x2){w[2], w[3]};
                    Ta = (f32x2){kd[0], kd[1]} * vv2 + Ta; Tb = (f32x2){kd[2], kd[3]} * vv2 + Tb;
                    Sa = (f32x2){nkka[0], nkka[1]} * sa2 + Ta; Sb = (f32x2){nkka[2], nkka[3]} * sa2 + Tb;
                    f32x2 uu = Sa * (f32x2){r[0], r[1]}; uu = Sb * (f32x2){r[2], r[3]} + uu;
                    qp = uu[0] + uu[1];
                }
                qp = row16_sum(qp);
                yacc = (ks == 15) ? qp : yacc;
                gb[12288 + (it & 1) * 256 + ks * 16 + rl] = yacc;
                if (!SD_LAT(t) && SD_CHUNK(t) == 15)
                    *(f32x4*)(p.out + (size_t)NTOK * D + ((size_t)((SD_SIDX(t) * 2 + SD_D(t)) * 16 + SD_H(t))) * 4096 + vrow * 64 + 4 * ks) = (f32x4){Sa[0], Sa[1], Sb[0], Sb[1]};
            }
            if (SD_ACT(tn)) {
                LAS float* sb = gb + ((it + 1) & 1) * 6144;
                const f32x4 r = h4_to_f4(q_r), k = h4_to_f4(q_k), v = h4_to_f4(q_v), w = h4_to_f4(q_w), a = h4_to_f4(q_a);
                const f32x4 kk = k * q_kk * q_inv, kd = k * ((a - 1.0f) * q_ka + 1.0f), nkka = kk * (-a);
                const int so = s_st * 64 + 4 * kq;
                *(LAS f32x4*)(sb + so) = w; *(LAS f32x4*)(sb + 1024 + so) = nkka; *(LAS f32x4*)(sb + 2048 + so) = kd; *(LAS f32x4*)(sb + 3072 + so) = r; *(LAS f32x4*)(sb + 4096 + so) = kk; *(LAS f32x4*)(sb + 5120 + so) = v;
            }
            __syncthreads();
        }
    }
}

__device__ __forceinline__ void p9_post(const Frame& F, const Params& p) {
    const f16* Y = (const f16*)(p.ws + OFF_Y); const f16* V = (const f16*)(p.ws + OFF_V); const f16* G = (const f16*)((const unsigned char*)p.out + 24 * MiB);
    const float* BC = (const float*)(p.ws + OFF_BC); f16* YO = (f16*)(p.ws + OFF_R);
    const float* lg = inp(F, 21); const float* lb = inp(F, 22);
    for (int row = F.gw; row < NTOK; row += F.NGW) {
#pragma unroll 1
        for (int jj = 0; jj < 4; ++jj) {
            const int c = 4 * F.lane + 256 * jj; const size_t o = (size_t)row * D + c;
            f32x4 y = h4_to_f4(*(const h4*)(Y + o));
            const float mean = xor16_sum((y[0] + y[1]) + (y[2] + y[3])) * (1.0f / 64.0f);
            y = y - mean;
            const float var = xor16_sum((y[0] * y[0] + y[1] * y[1]) + (y[2] * y[2] + y[3] * y[3])) * (1.0f / 64.0f);
            const float rs = 1.0f / sqrtf(var + 64e-5f);
            const float bc = BC[row * 16 + 4 * jj + (F.lane >> 4)];
            const f32x4 v = h4_to_f4(*(const h4*)(V + o)), g = h4_to_f4(*(const h4*)(G + o));
            const f32x4 out = (y * rs * *(const f32x4*)(lg + c) + *(const f32x4*)(lb + c) + v * bc) * g;
            *(h4*)(YO + o) = f4_to_h4(out);
        }
    }
}

__global__ void __launch_bounds__(512, 2) mega_fwd(Params p) {
    extern __shared__ __attribute__((aligned(16))) unsigned char lds_raw[];
    cg::grid_group grid = cg::this_grid();
    Frame F; F.lds = (LAS unsigned char*)lds_raw; F.tid = threadIdx.x; F.lane = F.tid & 63; F.wave = __builtin_amdgcn_readfirstlane(F.tid >> 6);
    F.epoch = 0; F.G = gridDim.x; F.bid = blockIdx.x; F.gw = F.bid * 8 + F.wave; F.NGW = F.G * 8;
    if (F.tid == 0) {
#pragma unroll
        for (int i = 0; i < 28; ++i) *(LAS unsigned long long*)(F.lds + LDS_TAB + 8 * i) = (unsigned long long)p.in[i];
    }
    __syncthreads();
    unsigned char* ws = p.ws; const float* mod = (const float*)(ws + OFF_MOD);
    unsigned char* G8 = (unsigned char*)p.out; f16* Gg = (f16*)((unsigned char*)p.out + 24 * MiB);
#ifndef REP_G
#define REP_G 1
#endif
#ifndef REP_B
#define REP_B 1
#endif
#ifndef REP_S
#define REP_S 1
#endif
#ifndef REP_E
#define REP_E 0
#endif
#define IN(k) (p.ph_lo <= (k) && (k) < p.ph_hi)
#define SEAM(k) do { if (IN(k) && IN((k) + 1)) { for (int rb_ = 0; rb_ < REP_B; ++rb_) xcd_barrier(xbar, F.tid); } \
    { int l_; asm volatile("v_mbcnt_lo_u32_b32 %0, -1, 0\n\tv_mbcnt_hi_u32_b32 %0, -1, %0" : "=v"(l_)); F.lane = l_; F.tid = F.wave * 64 + l_; } } while (0)
    if (p.ph_hi == 0x7fffffff) grid.sync();
    if (F.tid == 0) { *(LAS unsigned*)(F.lds + LDS_XB) = 0u; *(LAS unsigned*)(F.lds + LDS_XB + 4) = 0u; }
    __syncthreads();
    XcdBarrier xbar = xcd_barrier_post((unsigned*)ws, (volatile LAS unsigned*)(F.lds + LDS_XB), F.tid);
    { int l_; asm volatile("v_mbcnt_lo_u32_b32 %0, -1, 0\n\tv_mbcnt_hi_u32_b32 %0, -1, %0" : "=v"(l_)); F.lane = l_; F.tid = F.wave * 64 + l_; }
    if (IN(0)) for (int rep_ = 0; rep_ < ((REP_E & 1) ? 2 : 1); ++rep_) { p0_prologue(F, p); __syncthreads(); }
    SEAM(0);
    if (IN(1)) for (int rep_ = 0; rep_ < ((REP_E & 2) ? 2 : 1); ++rep_) p1_h1(F, p);
    SEAM(1);
    if (IN(2)) { EpiSwiGLU E{(f16*)(ws + OFF_BIG)}; run_gemm(F, ws + OFF_H, ws + OFF_FFNIN, 2 * DFF, D, E); if (REP_G > 1) { run_gemm(F, ws + OFF_H, ws + OFF_FFNIN, 2 * DFF, D, E); } }
    SEAM(2);
    if (IN(3)) { EpiResid<0> E{inp(F, 0), inp(F, 1), nullptr, p.out, mod, 2, 0.5f}; run_gemm(F, ws + OFF_BIG, ws + OFF_FFNOUT, D, DFF, E); if (REP_G > 1) { run_gemm(F, ws + OFF_BIG, ws + OFF_FFNOUT, D, DFF, E); } }
    SEAM(3);
    if (IN(4)) for (int rep_ = 0; rep_ < ((REP_E & 4) ? 2 : 1); ++rep_) ln_phase<false, true, true>(F, p, 0, 3, 4);
    SEAM(4);
    if (IN(5)) { EpiMixProj E{(f16*)(ws + OFF_BIG), G8}; run_gemm(F, ws + OFF_H, ws + OFF_MIXW, NMIX, D, E); if (REP_G > 1) { run_gemm(F, ws + OFF_H, ws + OFF_MIXW, NMIX, D, E); } }
    SEAM(5);
    if (IN(6)) for (int rep_ = 0; rep_ < ((REP_E & 8) ? 2 : 1); ++rep_) p6_prep(F, p);
    SEAM(6);
    if (IN(7)) { EpiLora E{(f16*)(ws + OFF_W), (f16*)(ws + OFF_A), Gg, inp(F, 13), inp(F, 15)}; run_gemm(F, ws + OFF_LA, ws + OFF_LORA, LORA_N, LORA_K, E); if (REP_G > 1) { run_gemm(F, ws + OFF_LA, ws + OFF_LORA, LORA_N, LORA_K, E); } }
    SEAM(7);
    if (IN(8)) p8_scan(F, p);
#if REP_S > 1
    xcd_barrier(xbar, F.tid);
    { const int gt = F.bid * 512 + F.tid, NT = F.G * 512; f32x4* Y4 = (f32x4*)(p.ws + OFF_Y);
      for (int i = gt; i < NTOK * D * 2 / 16; i += NT) Y4[i] = (f32x4){0.f, 0.f, 0.f, 0.f}; }
    xcd_barrier(xbar, F.tid);
    p8_scan(F, p);
#endif
    SEAM(8);
    if (IN(9)) { for (int rep_ = 0; rep_ < ((REP_E & 16) ? 2 : 1); ++rep_) p9_post(F, p); __syncthreads(); EpiPool E{G8, (f16*)(ws + OFF_K)}; run_gemm(F, ws + OFF_PR, ws + OFF_PB, D, 512, E); }
    SEAM(9);
    if (IN(10)) { EpiMerge E{G8, (const f16*)(ws + OFF_K), (f16*)(ws + OFF_BIG)}; run_gemm(F, ws + OFF_R, ws + OFF_ORWKV, D, D, E); if (REP_G > 1) { run_gemm(F, ws + OFF_R, ws + OFF_ORWKV, D, D, E); } }
    SEAM(10);
    if (IN(11)) { EpiResid<1> E{nullptr, nullptr, (const f16*)(ws + OFF_X1H), p.out, mod, 5, 1.0f}; run_gemm(F, ws + OFF_BIG, ws + OFF_OUTW, D, D, E); if (REP_G > 1) { run_gemm(F, ws + OFF_BIG, ws + OFF_OUTW, D, D, E); } }
    SEAM(11);
    if (IN(12)) { ln_phase<true, false, true>(F, p, 1, 6, 7); __syncthreads(); convert_ffn(F, p, 1); }
    SEAM(12);
    if (IN(13)) { EpiSwiGLU E{(f16*)(ws + OFF_BIG)}; run_gemm(F, ws + OFF_H, ws + OFF_FFNIN, 2 * DFF, D, E); if (REP_G > 1) { run_gemm(F, ws + OFF_H, ws + OFF_FFNIN, 2 * DFF, D, E); } }
    SEAM(13);
    if (IN(14)) { EpiResid<2> E{nullptr, nullptr, nullptr, p.out, mod, 8, 0.5f}; run_gemm(F, ws + OFF_BIG, ws + OFF_FFNOUT, D, DFF, E); }
    SEAM(14);
    if (IN(15)) ln_phase<true, false, false>(F, p, 2, 0, 0);
}

extern "C" void kernel_launch(void* const* d_in, const int* in_sizes, int n_in, void* d_out, int out_size, void* d_ws, size_t ws_size, hipStream_t stream) {
    static int grid = 0;
    if (grid == 0) {
        if (n_in != 28 || ws_size < WS_END) { fprintf(stderr, "kernel_launch: need 28 inputs and %zu bytes of workspace (got %d, %zu)\n", (size_t)WS_END, n_in, ws_size); grid = -1; return; }
        int dev = 0, cus = 0, per_cu = 0;
        hipGetDevice(&dev); hipDeviceGetAttribute(&cus, hipDeviceAttributeMultiprocessorCount, dev);
        if (hipFuncSetAttribute((const void*)mega_fwd, hipFuncAttributeMaxDynamicSharedMemorySize, LDS_BYTES) != hipSuccess) { fprintf(stderr, "kernel_launch: hipFuncSetAttribute failed\n"); grid = -1; return; }
        if (hipOccupancyMaxActiveBlocksPerMultiprocessor(&per_cu, (const void*)mega_fwd, 512, LDS_BYTES) != hipSuccess || per_cu < 1) { fprintf(stderr, "kernel_launch: occupancy query says %d\n", per_cu); grid = -1; return; }
        grid = cus * per_cu; if (grid > 256) grid = 256;
        fprintf(stderr, "kernel_launch: grid %d (cus %d x %d)\n", grid, cus, per_cu);
    }
    if (grid < 0) return;
    Params p{};
    for (int i = 0; i < 28; ++i) p.in[i] = (const float*)d_in[i];
    p.out = (float*)d_out; p.ws = (unsigned char*)d_ws;
#if MK_MULTI
    for (int ph = 0; ph < 16; ++ph) { p.ph_lo = ph; p.ph_hi = ph + 1; hipLaunchKernelGGL(mega_fwd, dim3(grid), dim3(512), LDS_BYTES, stream, p); }
#else
    p.ph_lo = 0; p.ph_hi = 16;
    if (hipMemsetAsync(d_ws, 0, 16384, stream) != hipSuccess) { fprintf(stderr, "kernel_launch: memset failed\n"); return; }
    void* args[] = {&p};
    hipError_t e = hipLaunchCooperativeKernel((const void*)mega_fwd, dim3(grid), dim3(512), args, LDS_BYTES, stream);
    if (e != hipSuccess) fprintf(stderr, "kernel_launch: cooperative launch failed: %s (grid %d)\n", hipGetErrorString(e), grid);
#endif
}
```

```cpp
#include <hip/hip_runtime.h>
#include <hip/hip_cooperative_groups.h>
#include <cstdio>
#include <cstdint>
namespace cg = cooperative_groups;
#ifndef MK_MULTI
#define MK_MULTI 0
#endif
namespace pg8 {
#define PG8_LAS __attribute__((address_space(3)))
typedef unsigned short bf16_t;
typedef _Float16 bf16x8 __attribute__((ext_vector_type(8)));
typedef float f32x4 __attribute__((ext_vector_type(4)));
typedef unsigned u32x4 __attribute__((ext_vector_type(4)));
constexpr int BM = 256, BK = 64, HALF = 128, HTB = HALF * BK * 2  , STAGE_BYTES = 8 * HTB, NXCD = 8, WGM = 8;

__host__ __device__ __forceinline__ int lds_byte(int r, int c) { const int st = (r >> 4) * 2 + (c >> 5), rr = r & 15, cc = c & 31, ob = rr * 64 + cc * 2; return st * 1024 + (ob ^ (((ob >> 9) & 1) << 5)); }
__host__ __device__ __forceinline__ void stage_rc(int b, int& R, int& C) { const int st = b / 1024, sb = b % 1024, swz = sb ^ (((sb >> 9) & 1) << 5); R = (st >> 1) * 16 + swz / 64; C = (st & 1) * 32 + (swz % 64) / 2; }
__host__ __device__ __forceinline__ int perm32(int rho) { const int n = rho >> 4, i = rho & 15; return 8 * (i >> 2) + 4 * n + (i & 3); }

struct Unit { int pm, pn; };
struct Gemm { const bf16_t* A; const bf16_t* Bt; int M, N, K; };

struct StaticOrder {
    int nM, nN, nwg, G, c;
    __host__ __device__ void init(int M, int N, int G_, int c_) { nM = M / BM; nN = N / BM; nwg = nM * nN; G = G_; c = c_; }
    __host__ __device__ bool next(int i, Unit& u) const {
        const long L = (long)i * G + c; if (L >= nwg) return false;
        int wgid = (int)L; { const int q = nwg / NXCD, r = nwg % NXCD, xcd = wgid % NXCD, off = wgid / NXCD; wgid = (xcd < r ? xcd * (q + 1) : r * (q + 1) + (xcd - r) * q) + off; }
        const int nig = WGM * nN, gid = wgid / nig, fm = gid * WGM, gsz = (nM - fm) < WGM ? (nM - fm) : WGM;
        u.pm = fm + ((wgid % nig) % gsz); u.pn = (wgid % nig) / gsz; return true;
    }
    __device__ __forceinline__ void a_ready(const Unit&) const {}
    __device__ __forceinline__ void done(const Unit&) const {}
};
template <class Epi, class Sched, bool STAMP = false>
__device__ __forceinline__ void gemm_phase(PG8_LAS unsigned char* lds, const Gemm g, const Sched& S, const Epi& E, unsigned long long* stamps, int tid_in) {
    const int tid = tid_in, wid = __builtin_amdgcn_readfirstlane(tid >> 6), lane = tid & 63, wr = wid >> 2, wc = wid & 3, fr = lane & 15, fq = lane >> 4;
    const int K = g.K, nt = K / BK;
    int ts_lo = 0, ts_hi = 0, nts = 0; const unsigned long long rt_entry = STAMP ? (unsigned long long)wall_clock64() : 0ull;
#define PG8_STAMP() do { if (STAMP && wid == 0 && nts < 64) { const unsigned long long _c = (unsigned long long)clock64(); \
        ts_lo = (lane == nts) ? (int)(unsigned)_c : ts_lo; ts_hi = (lane == nts) ? (int)(unsigned)(_c >> 32) : ts_hi; ++nts; } } while (0)
    PG8_STAMP();
    unsigned voffA[2], voffB[2];
#pragma unroll
    for (int i = 0; i < 2; ++i) { int R, C; stage_rc(tid * 16 + i * 8192, R, C); const int Rb = Epi::PERM ? ((R & ~31) + perm32(R & 31)) : R;
        voffA[i] = (unsigned)(R * K + C) * 2u; voffB[i] = (unsigned)(Rb * K + C) * 2u; }
    const size_t kstep = (size_t)(BK * 2);
    const size_t hstep = (size_t)HALF * K * 2;
    const size_t tstep = 2 * hstep;
    const unsigned ldsw = (unsigned)wid * 1024u;
    const int aoff = lds_byte(wr * 64 + fr, fq * 8), boff = lds_byte(wc * 32 + fr, fq * 8);
#define PG8_SA(b, h) (((b) * 2 + (h)) * HTB)
#define PG8_SB(b, h) ((4 + (b) * 2 + (h)) * HTB)
#define PG8_STAGE(bufoff, gbase, voff) do { _Pragma("unroll") for (int _i = 0; _i < 2; ++_i) \
        __builtin_amdgcn_global_load_lds((const unsigned*)((const char*)(gbase) + (voff)[_i]), (PG8_LAS unsigned*)(lds + (bufoff) + ldsw + _i * 8192), 16, 0, 0); } while (0)
#define PG8_LDA(dst, b, h) do { _Pragma("unroll") for (int m = 0; m < 4; ++m) _Pragma("unroll") for (int k = 0; k < 2; ++k) dst[m][k] = *(const PG8_LAS bf16x8*)(lds + PG8_SA(b, h) + aoff + m * 2048 + k * 1024); } while (0)
#define PG8_LDB(dst, b, h) do { _Pragma("unroll") for (int n = 0; n < 2; ++n) _Pragma("unroll") for (int k = 0; k < 2; ++k) dst[n][k] = *(const PG8_LAS bf16x8*)(lds + PG8_SB(b, h) + boff + n * 2048 + k * 1024); } while (0)
#define PG8_MMA(ai, bj, At, Bt) do { __builtin_amdgcn_s_setprio(1); _Pragma("unroll") for (int m = 0; m < 4; ++m) _Pragma("unroll") for (int n = 0; n < 2; ++n) _Pragma("unroll") for (int k = 0; k < 2; ++k) \
        acc[ai][bj][m][n] = __builtin_amdgcn_mfma_f32_16x16x32_f16(Bt[n][k], At[m][k], acc[ai][bj][m][n], 0, 0, 0); __builtin_amdgcn_s_setprio(0); } while (0)
#define PG8_WAIT_V(n) asm volatile("s_waitcnt vmcnt(" #n ")" ::: "memory")
#define PG8_WAIT_L(n) asm volatile("s_waitcnt lgkmcnt(" #n ")" ::: "memory")
#define PG8_BAR __builtin_amdgcn_s_barrier()
#define PG8_SCHED __builtin_amdgcn_sched_barrier(0)
    Unit cur, nxt; int ui = 0;
    if (!S.next(0, cur)) return;
    f32x4 acc[2][2][4][2];
#pragma unroll
    for (int a = 0; a < 2; ++a)
#pragma unroll
        for (int b = 0; b < 2; ++b)
#pragma unroll
            for (int m = 0; m < 4; ++m)
#pragma unroll
                for (int n = 0; n < 2; ++n) acc[a][b][m][n] = (f32x4){0.f, 0.f, 0.f, 0.f};
    bf16x8 At[4][2], B0[2][2], B1[2][2];
    const char* cA = (const char*)g.A + (size_t)cur.pm * tstep; const char* cB = (const char*)g.Bt + (size_t)cur.pn * tstep;
    S.a_ready(cur);
    PG8_STAGE(PG8_SB(0, 0), cB, voffB); PG8_STAGE(PG8_SA(0, 0), cA, voffA); PG8_STAGE(PG8_SB(0, 1), cB + hstep, voffB); PG8_STAGE(PG8_SA(0, 1), cA + hstep, voffA);
    if (wr == 1) PG8_BAR;
    PG8_WAIT_V(4); PG8_BAR;
    PG8_STAGE(PG8_SB(1, 0), cB + kstep, voffB); PG8_STAGE(PG8_SA(1, 0), cA + kstep, voffA); PG8_STAGE(PG8_SB(1, 1), cB + hstep + kstep, voffB);
    PG8_WAIT_V(6); PG8_BAR;
    PG8_STAMP();
    for (;;) {
        const bool has_next = S.next(ui + 1, nxt);
        const char* nA = has_next ? (const char*)g.A + (size_t)nxt.pm * tstep : cA; const char* nB = has_next ? (const char*)g.Bt + (size_t)nxt.pn * tstep : cB;
        for (int t = 0; t < nt; t += 2) {
            const bool last = (t == nt - 2);
            const char* a1 = cA + (size_t)(t + 1) * kstep;
            const char* a2 = last ? nA : cA + (size_t)(t + 2) * kstep; const char* b2 = last ? nB : cB + (size_t)(t + 2) * kstep;
            const char* a3 = a2 + kstep; const char* b3 = b2 + kstep;
            if (last && has_next) S.a_ready(nxt);
            PG8_LDB(B0, 0, 0); PG8_SCHED; PG8_LDA(At, 0, 0); PG8_STAGE(PG8_SA(1, 1), a1 + hstep, voffA);
            PG8_WAIT_L(8); PG8_BAR; PG8_WAIT_L(0); PG8_MMA(0, 0, At, B0); PG8_BAR; PG8_SCHED;
            PG8_LDB(B1, 0, 1); PG8_STAGE(PG8_SB(0, 0), b2, voffB);
            PG8_BAR; PG8_WAIT_L(0); PG8_MMA(0, 1, At, B1); PG8_BAR;
            PG8_LDA(At, 0, 1); PG8_STAGE(PG8_SA(0, 0), a2, voffA);
            PG8_BAR; PG8_WAIT_L(0); PG8_MMA(1, 0, At, B0); PG8_BAR; PG8_SCHED;
            PG8_STAGE(PG8_SB(0, 1), b2 + hstep, voffB);
            PG8_WAIT_V(6); PG8_BAR; PG8_MMA(1, 1, At, B1); PG8_BAR;
            PG8_LDB(B0, 1, 0); PG8_SCHED; PG8_LDA(At, 1, 0); PG8_STAGE(PG8_SA(0, 1), a2 + hstep, voffA);
            PG8_WAIT_L(8); PG8_BAR; PG8_WAIT_L(0); PG8_MMA(0, 0, At, B0); PG8_BAR; PG8_SCHED;
            PG8_LDB(B1, 1, 1); PG8_STAGE(PG8_SB(1, 0), b3, voffB);
            PG8_BAR; PG8_WAIT_L(0); PG8_MMA(0, 1, At, B1); PG8_BAR;
            PG8_LDA(At, 1, 1); PG8_STAGE(PG8_SA(1, 0), a3, voffA);
            PG8_BAR; PG8_WAIT_L(0); PG8_MMA(1, 0, At, B0); PG8_BAR; PG8_SCHED;
            PG8_STAGE(PG8_SB(1, 1), b3 + hstep, voffB);
            PG8_WAIT_V(6); PG8_BAR; PG8_MMA(1, 1, At, B1); PG8_BAR;
        }
        PG8_STAMP();
        if constexpr (!Epi::AFTER_DRAIN) { int fr_ = fr, fq_ = fq; asm volatile("" : "+v"(fr_), "+v"(fq_)); E(acc, cur, wr, wc, fr_, fq_); S.done(cur); }
        PG8_STAMP();
        if (!has_next) break;
#pragma unroll
        for (int a = 0; a < 2; ++a)
#pragma unroll
            for (int b = 0; b < 2; ++b)
#pragma unroll
                for (int m = 0; m < 4; ++m)
#pragma unroll
                    for (int n = 0; n < 2; ++n) acc[a][b][m][n] = (f32x4){0.f, 0.f, 0.f, 0.f};
        cur = nxt; cA = nA; cB = nB; ++ui;
    }
    PG8_WAIT_V(0);
    if (wr == 0) PG8_BAR;
    PG8_BAR;
    if constexpr (Epi::AFTER_DRAIN) { E.fused(acc, cur, wr, wc, fr, fq, lds, wid, lane); S.done(cur); }
    PG8_STAMP();
    if (STAMP && wid == 0) { stamps[lane] = lane < nts ? (((unsigned long long)(unsigned)ts_hi << 32) | (unsigned)ts_lo) : 0ull;
        if (lane == 62) stamps[62] = rt_entry; if (lane == 63) stamps[63] = (unsigned long long)wall_clock64(); }
#undef PG8_STAMP
#undef PG8_SA
#undef PG8_SB
#undef PG8_STAGE
#undef PG8_LDA
#undef PG8_LDB
#undef PG8_MMA
#undef PG8_WAIT_V
#undef PG8_WAIT_L
#undef PG8_BAR
#undef PG8_SCHED
}
}
#define LAS __attribute__((address_space(3)))
#define XB_TMO      128
#define XB_XCNT(j)  (256  + 64 * (j))
#define XB_XSUB(j)  (1280 + 64 * (j))
#define XB_XGEN(j)  (2304 + 64 * (j))
#define XB_TOP      3328
#define XB_TOPGEN   3392
#define XCD_BAR_WORDS 3456
#define XB_SPIN_CAP (1u << 18)

__device__ __forceinline__ unsigned xb_ld(unsigned* p)              { return __hip_atomic_load(p, __ATOMIC_RELAXED, __HIP_MEMORY_SCOPE_AGENT); }
__device__ __forceinline__ unsigned xb_add(unsigned* p, unsigned v) { return __hip_atomic_fetch_add(p, v, __ATOMIC_RELAXED, __HIP_MEMORY_SCOPE_AGENT); }
__device__ __forceinline__ unsigned xb_xcc_id() { return (unsigned)__builtin_amdgcn_s_getreg((3 << 11) | 20) & 0xFu; }
#define XB_SPIN(cond, bar) do { unsigned _sp = 0; while (cond) { __builtin_amdgcn_s_sleep(1); \
    if ((++_sp & 255u) == 0u) { if (xb_ld(&(bar)[XB_TMO])) break; if (_sp > XB_SPIN_CAP) { atomicAdd(&(bar)[XB_TMO], 1u); break; } } } } while (0)

struct XcdBarrier {
    unsigned* bar; unsigned x;
    volatile LAS unsigned* st;
};

__device__ __forceinline__ XcdBarrier xcd_barrier_post(unsigned* bar, volatile LAS unsigned* st, int tid) {
    XcdBarrier b; b.bar = bar; b.x = xb_xcc_id(); b.st = st;
    if (tid == 0) (void)xb_add(&bar[XB_XCNT(b.x)], 1u);
    return b;
}
__device__ __forceinline__ void xcd_barrier_complete(unsigned* bar, unsigned x, unsigned& nloc, unsigned& nx) {
    const unsigned G = gridDim.x * gridDim.y * gridDim.z;
    unsigned sum, cnt, mine, sp = 0u;
    for (;;) {
        sum = 0u; cnt = 0u; mine = 0u;
#pragma unroll
        for (unsigned j = 0; j < 16; ++j) { const unsigned c = xb_ld(&bar[XB_XCNT(j)]); sum += c; cnt += (c > 0u) ? 1u : 0u; mine = (j == x) ? c : mine; }
        if (sum == G) break;
        __builtin_amdgcn_s_sleep(1);
        if ((++sp & 255u) == 0u) { if (xb_ld(&bar[XB_TMO])) break; if (sp > XB_SPIN_CAP) { atomicAdd(&bar[XB_TMO], 1u); break; } }
    }
    nloc = mine > 0u ? mine : 1u; nx = cnt > 0u ? cnt : 1u;
}

__device__ __forceinline__ void xcd_barrier(const XcdBarrier& b, int tid) {
    asm volatile("s_waitcnt vmcnt(0)" ::: "memory");
    __syncthreads();
    if (tid == 0) {
        unsigned* bar = b.bar;
        __builtin_amdgcn_s_waitcnt(0);
        unsigned nloc = b.st[0], nx = b.st[1];
        if (nloc == 0u) { xcd_barrier_complete(bar, b.x, nloc, nx); b.st[0] = nloc; b.st[1] = nx; }
        const unsigned old = xb_add(&bar[XB_XSUB(b.x)], 1u);
        const unsigned gen = old / nloc;
        if (old + 1u == (gen + 1u) * nloc) {
            __builtin_amdgcn_fence(__ATOMIC_RELEASE, "agent");
            asm volatile("s_waitcnt vmcnt(0)" ::: "memory");
            const unsigned og = xb_add(&bar[XB_TOP], 1u);
            const unsigned tg = og / nx;
            if (og + 1u == (tg + 1u) * nx) xb_add(&bar[XB_TOPGEN], 1u);
            else XB_SPIN(xb_ld(&bar[XB_TOPGEN]) == tg, bar);
            __builtin_amdgcn_fence(__ATOMIC_ACQUIRE, "agent");
            xb_add(&bar[XB_XGEN(b.x)], 1u);
            asm volatile("s_waitcnt vmcnt(0)" ::: "memory");
        } else {
            XB_SPIN(xb_ld(&bar[XB_XGEN(b.x)]) == gen, bar);
            __builtin_amdgcn_fence(__ATOMIC_ACQUIRE, "agent");
            asm volatile("s_waitcnt vmcnt(0)" ::: "memory");
        }
    }
    __syncthreads();
}


typedef _Float16 f16;
typedef _Float16 h8 __attribute__((ext_vector_type(8)));
typedef _Float16 h4 __attribute__((ext_vector_type(4)));
typedef _Float16 h2 __attribute__((ext_vector_type(2)));
typedef float f32x4 __attribute__((ext_vector_type(4)));
typedef unsigned u32x2 __attribute__((ext_vector_type(2)));
using pg8::Unit;

constexpr int D = 1024, NTOK = 12288, NCTX = 4096, DFF = 2816, PROJ_LD = 3968, NMIX = 6144, NMIX_REAL = 6016, LORA_K = 384, LORA_N = 5120;
constexpr float ALPHA = 1.189207115002721f;
constexpr size_t MiB = 1048576;
constexpr size_t OFF_MOD = 16384, OFF_INV = 131072, OFF_BC = 917504;
constexpr size_t OFF_LORA = 2 * MiB, OFF_ORWKV = OFF_LORA + 3932160, OFF_OUTW = OFF_ORWKV + 2 * MiB, OFF_PB = OFF_OUTW + 2 * MiB;
constexpr size_t OFF_FFNIN = OFF_PB + 1 * MiB, OFF_FFNOUT = OFF_FFNIN + 11 * MiB, OFF_MIXW = OFF_FFNOUT + 5767168;
constexpr size_t OFF_Y = OFF_FFNIN;
constexpr size_t OFF_X1H = OFF_MIXW + 12 * MiB;
constexpr size_t OFF_H = OFF_X1H + 24 * MiB, OFF_LA = OFF_H, OFF_PR = OFF_H + 9 * MiB;
constexpr size_t OFF_BIG = OFF_H + 24 * MiB;
constexpr size_t OFF_W = OFF_BIG, OFF_A = OFF_BIG + 48 * MiB;
constexpr size_t OFF_R = OFF_BIG + 96 * MiB, OFF_K = OFF_R + 24 * MiB, OFF_V = OFF_K + 24 * MiB;
constexpr size_t WS_END = OFF_V + 24 * MiB;
static_assert(OFF_X1H == 41156608 && WS_END <= 268435456, "workspace map");
constexpr int LDS_TAB = 131072, LDS_XB = 131072 + 240, LDS_BYTES = 131072 + 256;

struct Params { const float* in[28]; float* out; unsigned char* ws; int ph_lo, ph_hi; };

__device__ __forceinline__ float sigmoidf_(float x) { return __builtin_amdgcn_rcpf(1.0f + __expf(-x)); }
__device__ __forceinline__ float siluf_(float x) { return x * __builtin_amdgcn_rcpf(1.0f + __expf(-x)); }
__device__ __forceinline__ f32x4 h4_to_f4(h4 v) { return (f32x4){(float)v[0], (float)v[1], (float)v[2], (float)v[3]}; }
__device__ __forceinline__ h4 f4_to_h4(f32x4 v) { return (h4){(f16)v[0], (f16)v[1], (f16)v[2], (f16)v[3]}; }
__device__ __forceinline__ h8 f8_to_h8(f32x4 a, f32x4 b) { return (h8){(f16)a[0], (f16)a[1], (f16)a[2], (f16)a[3], (f16)b[0], (f16)b[1], (f16)b[2], (f16)b[3]}; }
__device__ __forceinline__ float xor16_sum(float v) { v += __shfl_xor(v, 1); v += __shfl_xor(v, 2); v += __shfl_xor(v, 4); v += __shfl_xor(v, 8); return v; }
__device__ __forceinline__ float wave_sum(float v) {
#pragma unroll
    for (int o = 1; o < 64; o <<= 1) v += __shfl_xor(v, o);
    return v;
}
template <int CTRL> __device__ __forceinline__ float dpp_add(float x) {
    return x + __int_as_float(__builtin_amdgcn_update_dpp(0, __float_as_int(x), CTRL, 0xf, 0xf, false));
}
__device__ __forceinline__ float row16_sum(float x) {
    x = dpp_add<0xB1>(x);
    x = dpp_add<0x4E>(x);
    x = dpp_add<0x141>(x);
    x = dpp_add<0x140>(x);
    return x;
}
__device__ __forceinline__ int mod_index(int row) { return row < NCTX ? 0 : (row < 2 * NCTX ? 1 : 2); }

struct EpiSwiGLU {
    static constexpr bool PERM = true, AFTER_DRAIN = false;
    f16* O;
    __device__ __forceinline__ void operator()(const f32x4 (&acc)[2][2][4][2], const Unit& u, int wr, int wc, int fr, int fq) const {
        const int row0 = u.pm * 256 + wr * 64 + fr, col0 = u.pn * 128 + wc * 32 + 8 * fq;
#pragma unroll
        for (int ai = 0; ai < 2; ++ai)
#pragma unroll
            for (int m = 0; m < 4; ++m) {
                f32x4 o0, o1;
#pragma unroll
                for (int j = 0; j < 4; ++j) { o0[j] = siluf_(acc[ai][0][m][0][j]) * acc[ai][1][m][0][j]; o1[j] = siluf_(acc[ai][0][m][1][j]) * acc[ai][1][m][1][j]; }
                *(h8*)(O + (size_t)(row0 + ai * 128 + m * 16) * DFF + col0) = f8_to_h8(o0, o1);
            }
    }
};
template <int SRC  > struct EpiResid {
    static constexpr bool PERM = false, AFTER_DRAIN = false;
    const float* xa; const float* xb; const f16* xh; float* out; const float* mod; int mg; float coef;
    __device__ __forceinline__ void operator()(const f32x4 (&acc)[2][2][4][2], const Unit& u, int wr, int wc, int fr, int fq) const {
        const int midx = u.pm < 16 ? 0 : (u.pm < 32 ? 1 : 2);
        const float* mrow = mod + (midx * 9 + mg) * D;
        const int row0 = u.pm * 256 + wr * 64 + fr, col0 = u.pn * 256 + wc * 32 + 4 * fq;
#pragma unroll
        for (int ai = 0; ai < 2; ++ai)
#pragma unroll
            for (int m = 0; m < 4; ++m) {
                const int row = row0 + ai * 128 + m * 16;
#pragma unroll
                for (int bj = 0; bj < 2; ++bj)
#pragma unroll
                    for (int n = 0; n < 2; ++n) {
                        const int c = col0 + bj * 128 + n * 16; f32x4 x;
                        const f32x4 mv = *(const f32x4*)(mrow + c) * coef;
                        if (SRC == 0) x = *(const f32x4*)((row < NCTX ? xa + (size_t)row * D : xb + (size_t)(row - NCTX) * D) + c);
                        else if (SRC == 1) x = h4_to_f4(*(const h4*)(xh + (size_t)row * D + c));
                        else x = *(const f32x4*)(out + (size_t)row * D + c);
                        *(f32x4*)(out + (size_t)row * D + c) = x * ALPHA + mv * acc[ai][bj][m][n];
                    }
                asm volatile("" ::: "memory");
            }
    }
};
__device__ __forceinline__ unsigned pack_u8x4(f32x4 v) {
    const unsigned a = (unsigned)(v[0] * 255.0f + 0.5f), b = (unsigned)(v[1] * 255.0f + 0.5f), c = (unsigned)(v[2] * 255.0f + 0.5f), d = (unsigned)(v[3] * 255.0f + 0.5f);
    return a | (b << 8) | (c << 16) | (d << 24);
}
__device__ __forceinline__ f32x4 unpack_u8x4(unsigned w) {
    return (f32x4){(float)(w & 255u), (float)((w >> 8) & 255u), (float)((w >> 16) & 255u), (float)(w >> 24)} * (1.0f / 255.0f);
}
struct EpiMixProj {
    static constexpr bool PERM = true, AFTER_DRAIN = false;
    f16* PS; unsigned char* G8;
    __device__ __forceinline__ void operator()(const f32x4 (&acc)[2][2][4][2], const Unit& u, int wr, int wc, int fr, int fq) const {
        const int row0 = u.pm * 256 + wr * 64 + fr;
#pragma unroll
        for (int bj = 0; bj < 2; ++bj) {
            const int gc0 = u.pn * 256 + bj * 128;
            if (gc0 >= NMIX_REAL) continue;
            const int col = gc0 + wc * 32 + 8 * fq;
#pragma unroll
            for (int ai = 0; ai < 2; ++ai)
#pragma unroll
                for (int m = 0; m < 4; ++m) {
                    const int row = row0 + ai * 128 + m * 16;
                    const f32x4 v0 = acc[ai][bj][m][0], v1 = acc[ai][bj][m][1];
                    if (gc0 < PROJ_LD) *(h8*)(PS + (size_t)row * PROJ_LD + col) = f8_to_h8(v0, v1);
                    else {
                        f32x4 s0, s1;
#pragma unroll
                        for (int j = 0; j < 4; ++j) { s0[j] = sigmoidf_(v0[j]); s1[j] = sigmoidf_(v1[j]); }
                        u32x2 w; w.x = pack_u8x4(s0); w.y = pack_u8x4(s1);
                        *(u32x2*)(G8 + (size_t)row * 2048 + (col - PROJ_LD)) = w;
                    }
                }
        }
    }
};
struct EpiLora {
    static constexpr bool PERM = true, AFTER_DRAIN = false;
    f16* W; f16* A; f16* G; const float* w0; const float* a0;
    __device__ __forceinline__ void operator()(const f32x4 (&acc)[2][2][4][2], const Unit& u, int wr, int wc, int fr, int fq) const {
        const int sec = u.pn >> 2, row0 = u.pm * 256 + wr * 64 + fr;
        f16* dst = sec < 2 ? W + (size_t)sec * NTOK * D : (sec < 4 ? A + (size_t)(sec - 2) * NTOK * D : G);
        const float* bias = sec < 2 ? w0 + sec * D : a0 + (sec & 1) * D;
        const float bsc = sec < 4 ? 1.0f : 0.0f;
#pragma unroll
        for (int bj = 0; bj < 2; ++bj) {
            const int c = (u.pn & 3) * 256 + bj * 128 + wc * 32 + 8 * fq;
            const f32x4 b0 = *(const f32x4*)(bias + c) * bsc, b1 = *(const f32x4*)(bias + c + 4) * bsc;
#pragma unroll
            for (int ai = 0; ai < 2; ++ai)
#pragma unroll
                for (int m = 0; m < 4; ++m) {
                    const int row = row0 + ai * 128 + m * 16;
                    f32x4 v0 = acc[ai][bj][m][0] + b0, v1 = acc[ai][bj][m][1] + b1;
#pragma unroll
                    for (int j = 0; j < 4; ++j) {
                        const float s0 = sigmoidf_(v0[j]), s1 = sigmoidf_(v1[j]);
                        const float e0 = __expf(-0.6065306597126334f * s0), e1 = __expf(-0.6065306597126334f * s1);
                        v0[j] = sec < 2 ? e0 : (sec < 4 ? s0 : v0[j]); v1[j] = sec < 2 ? e1 : (sec < 4 ? s1 : v1[j]);
                    }
                    *(h8*)(dst + (size_t)row * D + c) = f8_to_h8(v0, v1);
                    __builtin_amdgcn_sched_barrier(0);
                }
        }
    }
};
struct EpiPool {
    static constexpr bool PERM = true, AFTER_DRAIN = false;
    const unsigned char* G8; f16* GBYB;
    __device__ __forceinline__ void operator()(const f32x4 (&acc)[2][2][4][2], const Unit& u, int wr, int wc, int fr, int fq) const {
        const int row0 = u.pm * 256 + wr * 64 + fr;
#pragma unroll
        for (int bj = 0; bj < 2; ++bj) {
            const int c = u.pn * 256 + bj * 128 + wc * 32 + 8 * fq;
#pragma unroll
            for (int ai = 0; ai < 2; ++ai)
#pragma unroll
                for (int m = 0; m < 4; ++m) {
                    const int row = row0 + ai * 128 + m * 16;
                    const u32x2 g = *(const u32x2*)(G8 + (size_t)row * 2048 + 1024 + c);
                    *(h8*)(GBYB + (size_t)row * D + c) = f8_to_h8(unpack_u8x4(g.x) * acc[ai][bj][m][0], unpack_u8x4(g.y) * acc[ai][bj][m][1]);
                }
        }
    }
};
struct EpiMerge {
    static constexpr bool PERM = true, AFTER_DRAIN = false;
    const unsigned char* G8; const f16* GBYB; f16* MG;
    __device__ __forceinline__ void operator()(const f32x4 (&acc)[2][2][4][2], const Unit& u, int wr, int wc, int fr, int fq) const {
        const int row0 = u.pm * 256 + wr * 64 + fr;
#pragma unroll
        for (int bj = 0; bj < 2; ++bj) {
            const int c = u.pn * 256 + bj * 128 + wc * 32 + 8 * fq;
#pragma unroll
            for (int ai = 0; ai < 2; ++ai)
#pragma unroll
                for (int m = 0; m < 4; ++m) {
                    const int row = row0 + ai * 128 + m * 16;
                    const u32x2 g = *(const u32x2*)(G8 + (size_t)row * 2048 + c);
                    const h8 yb = *(const h8*)(GBYB + (size_t)row * D + c);
                    f32x4 o0 = unpack_u8x4(g.x) * acc[ai][bj][m][0], o1 = unpack_u8x4(g.y) * acc[ai][bj][m][1];
#pragma unroll
                    for (int j = 0; j < 4; ++j) { o0[j] += (float)yb[j]; o1[j] += (float)yb[4 + j]; }
                    *(h8*)(MG + (size_t)row * D + c) = f8_to_h8(o0, o1);
                }
        }
    }
};

struct Frame { LAS unsigned char* lds; int tid, lane, wave, G, bid, gw, NGW, epoch; };
#define LDS_WAIT() asm volatile("s_waitcnt lgkmcnt(0)" ::: "memory")
__device__ __forceinline__ const float* inp(const Frame& F, int i) {
    const unsigned long long v = *(const LAS unsigned long long*)(F.lds + LDS_TAB + 8 * i);
    const unsigned lo = __builtin_amdgcn_readfirstlane((unsigned)v), hi = __builtin_amdgcn_readfirstlane((unsigned)(v >> 32));
    return (const float*)(((unsigned long long)hi << 32) | lo);
}

template <class Epi> __device__ __forceinline__ void run_gemm(const Frame& F, const void* A, const void* Bt, int N, int K, const Epi& E) {
    asm volatile("" : "+s"(K));
    pg8::Gemm g{(const pg8::bf16_t*)A, (const pg8::bf16_t*)Bt, NTOK, N, K};
    pg8::StaticOrder S; S.init(NTOK, N, F.G, F.bid);
    pg8::gemm_phase<Epi, pg8::StaticOrder>(F.lds, g, S, E, nullptr, F.tid);
}

__device__ __forceinline__ void tr_item(const float* W, int ldw, int srccol0, int k0, f16* WT, int ldk, int dstrow0, LAS float* scr, int lane) {
#pragma unroll
    for (int i = 0; i < 32; ++i) { const int kk = 2 * i + (lane >> 5); scr[kk * 33 + (lane & 31)] = W[(size_t)(k0 + kk) * ldw + srccol0 + (lane & 31)]; }
    LDS_WAIT();
    const int c = lane & 7;
#pragma unroll
    for (int j = 0; j < 4; ++j) { const int n = (lane >> 3) + 8 * j; const LAS float* s = scr + (8 * c) * 33 + n;
        h8 o = (h8){(f16)s[0], (f16)s[33], (f16)s[66], (f16)s[99], (f16)s[132], (f16)s[165], (f16)s[198], (f16)s[231]};
        *(h8*)(WT + (size_t)(dstrow0 + n) * ldk + k0 + 8 * c) = o; }
    LDS_WAIT();
}
__device__ __forceinline__ int ffn_in_srccol(int n0) { const int u = n0 >> 8, i = n0 & 255; return i < 128 ? 128 * u + i : DFF + 128 * u + (i - 128); }
__device__ __forceinline__ void convert_ffn(const Frame& F, const Params& p, int l) {
    LAS float* scr = (LAS float*)(F.lds + F.wave * 8448);
    const float* fin = inp(F, 9) + (size_t)l * D * 2 * DFF; const float* fout = inp(F, 10) + (size_t)l * DFF * D;
    f16* FI = (f16*)(p.ws + OFF_FFNIN); f16* FO = (f16*)(p.ws + OFF_FFNOUT);
    constexpr int I1 = 16 * 176, I2 = 44 * 32;
    for (int it = F.gw; it < I1 + I2; it += F.NGW) {
        if (it < I1) { const int nb = it % 176, kb = it / 176; tr_item(fin, 2 * DFF, ffn_in_srccol(32 * nb), 64 * kb, FI, D, 32 * nb, scr, F.lane); }
        else { const int r = it - I1, nb = r % 32, kb = r / 32; tr_item(fout, D, 32 * nb, 64 * kb, FO, DFF, 32 * nb, scr, F.lane); }
    }
}

__device__ __forceinline__ void p0_prologue(const Frame& F, const Params& p) {
    for (int it = F.bid; it < 144; it += F.G) {
        const int l4 = F.tid & 15, kg = F.tid >> 4;
        const float* wm = inp(F, 5); const float* cc = inp(F, 2); const float* cx = inp(F, 4);
        f32x4 a0 = (f32x4){0.f, 0.f, 0.f, 0.f}, a1 = a0, a2 = a0;
#pragma unroll 4
        for (int kk = 0; kk < 32; ++kk) { const int k = 32 * kg + kk;
            const f32x4 w = *(const f32x4*)(wm + (size_t)k * 9216 + 64 * it + 4 * l4);
            a0 += w * siluf_(cx[k]); a1 += w * siluf_(cc[k]); a2 += w * siluf_(cc[D + k]); }
        LAS float* red = (LAS float*)F.lds;
        *(LAS f32x4*)(red + (kg * 3 + 0) * 64 + 4 * l4) = a0; *(LAS f32x4*)(red + (kg * 3 + 1) * 64 + 4 * l4) = a1; *(LAS f32x4*)(red + (kg * 3 + 2) * 64 + 4 * l4) = a2;
        __syncthreads();
        if (F.tid < 192) { const int i = F.tid >> 6, c = F.tid & 63; float s = 0.f;
            for (int g = 0; g < 32; ++g) s += red[(g * 3 + i) * 64 + c];
            ((float*)(p.ws + OFF_MOD))[i * 9216 + 64 * it + c] = s + inp(F, 6)[64 * it + c]; }
        __syncthreads();
    }
    convert_ffn(F, p, 0);
    {
        LAS float* scr = (LAS float*)(F.lds + F.wave * 8448);
        f16* MX = (f16*)(p.ws + OFF_MIXW); f16* WO = (f16*)(p.ws + OFF_ORWKV); f16* WU = (f16*)(p.ws + OFF_OUTW);
        constexpr int I1 = 16 * 188, I2 = 16 * 32;
        for (int it = F.gw; it < I1 + 2 * I2; it += F.NGW) {
            if (it < I1) { const int nb = it % 188, kb = it / 188; tr_item(inp(F, 11), NMIX_REAL, 32 * nb, 64 * kb, MX, D, 32 * nb, scr, F.lane); }
            else if (it < I1 + I2) { const int r = it - I1, nb = r % 32, kb = r / 32; tr_item(inp(F, 23), D, 32 * nb, 64 * kb, WO, D, 32 * nb, scr, F.lane); }
            else { const int r = it - I1 - I2, nb = r % 32, kb = r / 32; tr_item(inp(F, 27), D, 32 * nb, 64 * kb, WU, D, 32 * nb, scr, F.lane); }
        }
        const int gt = F.bid * 512 + F.tid, NT = F.G * 512;
        for (int i = gt; i < 128 * D / 8; i += NT) *(h8*)(MX + (size_t)NMIX_REAL * D + (size_t)i * 8) = (h8){0, 0, 0, 0, 0, 0, 0, 0};
        f16* LW = (f16*)(p.ws + OFF_LORA);
        for (int i = gt; i < LORA_N * 48; i += NT) {
            const int n = i % LORA_N, k8 = (i / LORA_N) * 8, sec = n >> 10, c = n & 1023;
            const float* src; int koff, klen;
            if (sec == 0) { src = inp(F, 14); koff = 0; klen = 64; } else if (sec == 1) { src = inp(F, 14) + 64 * D; koff = 64; klen = 64; }
            else if (sec == 2) { src = inp(F, 16); koff = 128; klen = 64; } else if (sec == 3) { src = inp(F, 16) + 64 * D; koff = 192; klen = 64; }
            else { src = inp(F, 17); koff = 256; klen = 128; }
            h8 o = (h8){0, 0, 0, 0, 0, 0, 0, 0};
            if (k8 >= koff && k8 < koff + klen) {
#pragma unroll
                for (int e = 0; e < 8; ++e) o[e] = (f16)src[(size_t)(k8 - koff + e) * D + c];
            }
            *(h8*)(LW + (size_t)n * LORA_K + k8) = o;
        }
        f16* PBW = (f16*)(p.ws + OFF_PB);
        for (int i = gt; i < 1024 * 64; i += NT) {
            const int n = i & 1023, k0 = (i >> 10) * 8, g = k0 >> 7, c0 = k0 & 127;
            const float* wp = inp(F, 24) + (size_t)g * 128 * 128 + (size_t)c0 * 128; const float* ps = inp(F, 25) + g * 128; const float* wo = inp(F, 26) + (size_t)g * 128 * D + n;
            float a[8] = {0.f, 0.f, 0.f, 0.f, 0.f, 0.f, 0.f, 0.f};
#pragma unroll 8
            for (int d = 0; d < 128; ++d) { const float t = ps[d] * wo[(size_t)d * D];
#pragma unroll
                for (int e = 0; e < 8; ++e) a[e] += wp[e * 128 + d] * t; }
            *(h8*)(PBW + (size_t)n * 512 + k0) = (h8){(f16)a[0], (f16)a[1], (f16)a[2], (f16)a[3], (f16)a[4], (f16)a[5], (f16)a[6], (f16)a[7]};
        }
    }
}

__device__ __forceinline__ void p1_h1(const Frame& F, const Params& p) {
    const float* mod = (const float*)(p.ws + OFF_MOD); f16* H = (f16*)(p.ws + OFF_H);
    for (int row = F.gw; row < NTOK; row += F.NGW) {
        const float* x = row < NCTX ? inp(F, 0) + (size_t)row * D : inp(F, 1) + (size_t)(row - NCTX) * D;
        const float* m0 = mod + (mod_index(row) * 9 + 0) * D; const float* m1 = m0 + D;
#pragma unroll
        for (int j = 0; j < 4; ++j) { const int c = 4 * F.lane + 256 * j;
            const f32x4 v = *(const f32x4*)(x + c), a = *(const f32x4*)(m0 + c), b = *(const f32x4*)(m1 + c);
            *(h4*)(H + (size_t)row * D + c) = f4_to_h4(v * (b + 1.0f) + a); }
    }
}

template <bool WX32, bool WXH, bool WH> __device__ __forceinline__ void ln_phase(const Frame& F, const Params& p, int lni, int mh, int ms) {
    const float* mod = (const float*)(p.ws + OFF_MOD); f16* H = (f16*)(p.ws + OFF_H); f16* XH = (f16*)(p.ws + OFF_X1H);
    const float* g = inp(F, 7) + lni * D; const float* b = inp(F, 8) + lni * D;
    for (int row = F.gw; row < NTOK; row += F.NGW) {
        float* z = p.out + (size_t)row * D;
        f32x4 v[4]; float s = 0.f;
#pragma unroll
        for (int j = 0; j < 4; ++j) { v[j] = *(const f32x4*)(z + 4 * F.lane + 256 * j); s += (v[j][0] + v[j][1]) + (v[j][2] + v[j][3]); }
        const float mean = wave_sum(s) * (1.0f / D); float q = 0.f;
#pragma unroll
        for (int j = 0; j < 4; ++j) { v[j] = v[j] - mean; q += (v[j][0] * v[j][0] + v[j][1] * v[j][1]) + (v[j][2] * v[j][2] + v[j][3] * v[j][3]); }
        const float rstd = 1.0f / sqrtf(wave_sum(q) * (1.0f / D) + 1e-5f);
        const float* mrow = mod + (size_t)mod_index(row) * 9 * D;
#pragma unroll
        for (int j = 0; j < 4; ++j) { const int c = 4 * F.lane + 256 * j;
            const f32x4 x = v[j] * rstd * *(const f32x4*)(g + c) + *(const f32x4*)(b + c);
            if (WX32) *(f32x4*)(z + c) = x;
            if (WXH) *(h4*)(XH + (size_t)row * D + c) = f4_to_h4(x);
            if (WH) *(h4*)(H + (size_t)row * D + c) = f4_to_h4(x * (*(const f32x4*)(mrow + ms * D + c) + 1.0f) + *(const f32x4*)(mrow + mh * D + c)); }
    }
}

struct TokPos { int row, pos, T, lat; };
__device__ __forceinline__ f32x4 shift_mix4(const f16* PS, const float* mu, const TokPos& t, int col) {
    const f16* own = PS + (size_t)t.row * PROJ_LD + col;
    const f32x4 o = h4_to_f4(*(const h4*)own);
    f32x4 sh;
    if (!t.lat) {
        const f32x4 pv = t.pos > 0 ? h4_to_f4(*(const h4*)(own - PROJ_LD)) : (f32x4){0.f, 0.f, 0.f, 0.f};
        const f32x4 nx = t.pos < t.T - 1 ? h4_to_f4(*(const h4*)(own + PROJ_LD)) : (f32x4){0.f, 0.f, 0.f, 0.f};
        sh = (f32x4){pv[0], nx[1], pv[2], nx[3]};
    } else {
        const int gr = t.pos >> 6, gc = t.pos & 63;
        sh[0] = gc > 0 ? (float)own[-PROJ_LD + 0] : 0.f;
        sh[1] = gc < 63 ? (float)own[PROJ_LD + 1] : 0.f;
        sh[2] = gr > 0 ? (float)own[-64 * PROJ_LD + 2] : 0.f;
        sh[3] = gr < 63 ? (float)own[64 * PROJ_LD + 3] : 0.f;
    }
    const f32x4 m = *(const f32x4*)(mu + col);
    return o + m * (sh - o);
}
__device__ __forceinline__ void p6_prep(const Frame& F, const Params& p) {
    const f16* PS = (const f16*)(p.ws + OFF_BIG);
    f16* R = (f16*)(p.ws + OFF_R); f16* K = (f16*)(p.ws + OFF_K); f16* V = (f16*)(p.ws + OFF_V);
    f16* LA = (f16*)(p.ws + OFF_LA); f16* PR = (f16*)(p.ws + OFF_PR);
    float* INV = (float*)(p.ws + OFF_INV); float* BC = (float*)(p.ws + OFF_BC);
    const float* mu = inp(F, 12); const float* k_k = inp(F, 18); const float* r_k = inp(F, 20);
    { const int gt = F.bid * 512 + F.tid, NT = F.G * 512; f32x4* Y4 = (f32x4*)(p.ws + OFF_Y);
      for (int i = gt; i < NTOK * D * 2 / 16; i += NT) Y4[i] = (f32x4){0.f, 0.f, 0.f, 0.f}; }
    for (int row = F.gw; row < NTOK; row += F.NGW) {
        TokPos t; t.row = row;
        if (row < NCTX) { t.lat = 0; t.pos = row & 255; t.T = 256; } else { t.lat = 1; t.pos = (row - NCTX) & 4095; t.T = 4096; }
        const int lane = F.lane;
#pragma unroll
        for (int jj = 0; jj < 4; ++jj) {
            const int c = 4 * lane + 256 * jj;
            const f32x4 r = shift_mix4(PS, mu, t, c), k = shift_mix4(PS, mu, t, D + c), v = shift_mix4(PS, mu, t, 2 * D + c);
            *(h4*)(R + (size_t)row * D + c) = f4_to_h4(r); *(h4*)(K + (size_t)row * D + c) = f4_to_h4(k); *(h4*)(V + (size_t)row * D + c) = f4_to_h4(v);
            const f32x4 kk = k * *(const f32x4*)(k_k + c), rk = r * k * *(const f32x4*)(r_k + c);
            const float n2 = xor16_sum((kk[0] * kk[0] + kk[1] * kk[1]) + (kk[2] * kk[2] + kk[3] * kk[3]));
            const float bc = xor16_sum((rk[0] + rk[1]) + (rk[2] + rk[3]));
            if ((lane & 15) == 0) { const int h = 4 * jj + (lane >> 4); INV[row * 16 + h] = 1.0f / fmaxf(sqrtf(n2), 1e-12f); BC[row * 16 + h] = bc; }
        }
        {
            f32x4 x = shift_mix4(PS, mu, t, 3 * D + 4 * lane);
            if (lane < 32) {
#pragma unroll
                for (int j = 0; j < 4; ++j) x[j] = 1.0f - 2.0f * __builtin_amdgcn_rcpf(__expf(2.0f * x[j]) + 1.0f);
            }
            *(h4*)(LA + (size_t)row * LORA_K + 4 * lane) = f4_to_h4(x);
        }
        if (lane < 32) {
            f32x4 x = shift_mix4(PS, mu, t, 3 * D + 256 + 4 * lane);
#pragma unroll
            for (int j = 0; j < 4; ++j) x[j] = sigmoidf_(x[j]);
            *(h4*)(LA + (size_t)row * LORA_K + 256 + 4 * lane) = f4_to_h4(x);
        }
        {
            const int half = 1 << (lane >> 4);
            const int lo = max(t.pos - half, 0), hi = min(t.pos + half, t.T);
            const f16* base = PS + (size_t)(row - t.pos) * PROJ_LD + 3456 + 8 * lane;
            float s[8] = {0.f, 0.f, 0.f, 0.f, 0.f, 0.f, 0.f, 0.f};
#pragma unroll
            for (int qq = 0; qq < 16; ++qq) { const int q = lo + qq;
                if (q < hi) { const h8 x = *(const h8*)(base + (size_t)q * PROJ_LD);
#pragma unroll
                    for (int e = 0; e < 8; ++e) s[e] += (float)x[e]; } }
            const h8 self = *(const h8*)(base + (size_t)t.pos * PROJ_LD);
            const float inv = 1.0f / (float)(hi - lo);
            h8 o;
#pragma unroll
            for (int e = 0; e < 8; ++e) o[e] = (f16)(s[e] * inv - (float)self[e]);
            *(h8*)(PR + (size_t)row * 512 + 8 * lane) = o;
        }
    }
}

__device__ __forceinline__ int scan_desc(int grp, int vb, int it) {
    int dsc;
    if (grp == 0) { const int chain = vb >> 2; dsc = ((it >= 0 && it < 256) ? 1 : 0) | ((chain >> 5) << 1) | ((chain & 15) << 2) | ((vb & 3) << 6) | (((chain >> 4) & 1) << 8) | ((it & 255) << 12) | (1 << 20); }
    else { const int task = vb * 8 + ((it >> 4) & 7), chain = task >> 2; dsc = ((it >= 0 && it < 128) ? 1 : 0) | ((chain >> 8) << 1) | ((chain & 15) << 2) | ((task & 3) << 6) | (((chain >> 4) & 15) << 8) | ((it & 15) << 12); }
    dsc = __builtin_amdgcn_readfirstlane(dsc);
    asm volatile("" : "+s"(dsc));
    return dsc;
}
#define SD_ACT(x) ((x) & 1)
#define SD_D(x) (((x) >> 1) & 1)
#define SD_H(x) (((x) >> 2) & 15)
#define SD_RG(x) (((x) >> 6) & 3)
#define SD_SIDX(x) (((x) >> 8) & 15)
#define SD_CHUNK(x) (((x) >> 12) & 255)
#define SD_LAT(x) (((x) >> 20) & 1)
__device__ __forceinline__ int scan_row(int dsc, int s_) {
    const int lat = SD_LAT(dsc), T = lat ? 4096 : 256, seqbase = lat ? NCTX + SD_SIDX(dsc) * 4096 : SD_SIDX(dsc) * 256, tl = SD_CHUNK(dsc) * 16 + s_;
    return seqbase + (SD_D(dsc) ? T - 1 - tl : tl);
}
typedef float f32x2 __attribute__((ext_vector_type(2)));
struct ScanPref { h4 r, k, v, w, a; float inv; f32x4 kk, ka; };
__device__ __forceinline__ void scan_load(const Frame& F, const unsigned char* ws, ScanPref& P, int tn, int s_st, int kq) {
    if (SD_ACT(tn)) {
        const int row = scan_row(tn, s_st), col = SD_H(tn) * 64 + 4 * kq; const size_t o = ((size_t)row * D + col) * 2;
        P.r = *(const h4*)(ws + OFF_R + o); P.k = *(const h4*)(ws + OFF_K + o); P.v = *(const h4*)(ws + OFF_V + o);
        const size_t od = o + (size_t)SD_D(tn) * NTOK * D * 2;
        P.w = *(const h4*)(ws + OFF_W + od); P.a = *(const h4*)(ws + OFF_A + od);
        P.inv = ((const float*)(ws + OFF_INV))[row * 16 + SD_H(tn)]; P.kk = *(const f32x4*)(inp(F, 18) + col); P.ka = *(const f32x4*)(inp(F, 19) + col);
    }
}
__device__ __forceinline__ void scan_convert(LAS float* sb, const ScanPref& PC, int s_st, int kq) {
    const f32x4 r = h4_to_f4(PC.r), k = h4_to_f4(PC.k), v = h4_to_f4(PC.v), w = h4_to_f4(PC.w), a = h4_to_f4(PC.a);
    const f32x4 kk = k * PC.kk * PC.inv, kd = k * ((a - 1.0f) * PC.ka + 1.0f), nkka = kk * (-a);
    const int so = s_st * 64 + 4 * kq;
    *(LAS f32x4*)(sb + so) = w; *(LAS f32x4*)(sb + 1024 + so) = nkka; *(LAS f32x4*)(sb + 2048 + so) = kd; *(LAS f32x4*)(sb + 3072 + so) = r; *(LAS f32x4*)(sb + 4096 + so) = kk; *(LAS f32x4*)(sb + 5120 + so) = v;
}
__device__ __forceinline__ void scan_flush(unsigned char* ws, const LAS float* yb, int tp, int sid) {
    if (SD_ACT(tp) && sid < 128) {
        const int s_ = sid >> 3, pr = sid & 7, row = scan_row(tp, s_);
        const h2 val = (h2){(f16)yb[s_ * 16 + 2 * pr], (f16)yb[s_ * 16 + 2 * pr + 1]};
        __builtin_amdgcn_global_atomic_fadd_v2f16((__attribute__((address_space(1))) h2*)(ws + OFF_Y + ((size_t)row * D + SD_H(tp) * 64 + SD_RG(tp) * 16 + 2 * pr) * 2), val);
    }
}
__device__ __forceinline__ void scan_stage_iter(const Frame& F, unsigned char* ws, LAS float* lds, int vb, int it, ScanPref& PL0, ScanPref& PL1, const ScanPref& PC0, const ScanPref& PC1, int sid) {
    const int s_st = sid >> 4, kq = sid & 15;
    LAS float* g0 = lds; LAS float* g1 = lds + 13312;
    scan_load(F, ws, PL0, scan_desc(0, vb, it + 2), s_st, kq);
    scan_load(F, ws, PL1, scan_desc(1, vb, it + 2), s_st, kq);
    scan_flush(ws, g0 + 12288 + ((it - 1) & 1) * 256, scan_desc(0, vb, it - 1), sid);
    scan_flush(ws, g1 + 12288 + ((it - 1) & 1) * 256, scan_desc(1, vb, it - 1), sid);
    if (SD_ACT(scan_desc(0, vb, it + 1))) scan_convert(g0 + ((it + 1) & 1) * 6144, PC0, s_st, kq);
    if (SD_ACT(scan_desc(1, vb, it + 1))) scan_convert(g1 + ((it + 1) & 1) * 6144, PC1, s_st, kq);
}
#define SCAN_LOADS(sfx, sb, vrow) \
    const f32x4 w##sfx = *(const LAS f32x4*)(sb + s_ * 64 + 4 * ks), nkka##sfx = *(const LAS f32x4*)(sb + 1024 + s_ * 64 + 4 * ks), kd##sfx = *(const LAS f32x4*)(sb + 2048 + s_ * 64 + 4 * ks); \
    const f32x4 r##sfx = *(const LAS f32x4*)(sb + 3072 + s_ * 64 + 4 * ks), kk##sfx = *(const LAS f32x4*)(sb + 4096 + s_ * 64 + 4 * ks); \
    const float vv##sfx = sb[5120 + s_ * 64 + vrow]; \
    f32x2 tt##sfx = Sa##sfx * (f32x2){kk##sfx[0], kk##sfx[1]}; tt##sfx = Sb##sfx * (f32x2){kk##sfx[2], kk##sfx[3]} + tt##sfx; \
    float pp##sfx = tt##sfx[0] + tt##sfx[1];
#define SCAN_UPDATE(sfx) \
    yacc##sfx = (ks == s_ - 1) ? qp##sfx : yacc##sfx; \
    { const f32x2 vv2 = (f32x2){vv##sfx, vv##sfx}, sa2 = (f32x2){pp##sfx, pp##sfx}; \
      f32x2 Ta = Sa##sfx * (f32x2){w##sfx[0], w##sfx[1]}, Tb = Sb##sfx * (f32x2){w##sfx[2], w##sfx[3]}; \
      Ta = (f32x2){kd##sfx[0], kd##sfx[1]} * vv2 + Ta; Tb = (f32x2){kd##sfx[2], kd##sfx[3]} * vv2 + Tb; \
      Sa##sfx = (f32x2){nkka##sfx[0], nkka##sfx[1]} * sa2 + Ta; Sb##sfx = (f32x2){nkka##sfx[2], nkka##sfx[3]} * sa2 + Tb; \
      f32x2 uu = Sa##sfx * (f32x2){r##sfx[0], r##sfx[1]}; uu = Sb##sfx * (f32x2){r##sfx[2], r##sfx[3]} + uu; \
      qp##sfx = uu[0] + uu[1]; }
__device__ __forceinline__ void p8_scan(const Frame& F, const Params& p) {
    const int lane = F.lane, ks = lane & 15;
    LAS float* lds = (LAS float*)F.lds;
    LAS float* gL = lds; LAS float* gC = lds + 13312;
    unsigned char* ws = p.ws;
    const bool stager = F.wave >= 4;
    const int sid = F.tid - 256, rl = (F.wave & 3) * 4 + (lane >> 4);
    for (int vb = F.bid; vb < 256; vb += F.G) {
        if (stager) {
            ScanPref A0, A1, B0, B1;
            A0.r = (h4){0, 0, 0, 0}; A0.k = A0.r; A0.v = A0.r; A0.w = A0.r; A0.a = A0.r; A0.inv = 0.f; A0.kk = (f32x4){0.f, 0.f, 0.f, 0.f}; A0.ka = A0.kk; A1 = A0; B0 = A0; B1 = A0;
            scan_load(F, ws, B0, scan_desc(0, vb, 0), sid >> 4, sid & 15); scan_load(F, ws, B1, scan_desc(1, vb, 0), sid >> 4, sid & 15);
            for (int it = -1; it <= 256; it += 2) {
                scan_stage_iter(F, ws, lds, vb, it, A0, A1, B0, B1, sid); __syncthreads();
                scan_stage_iter(F, ws, lds, vb, it + 1, B0, B1, A0, A1, sid); __syncthreads();
            }
        } else {
            const int t0 = scan_desc(0, vb, 0);
            f32x4 S0 = *(const f32x4*)(inp(F, 3) + ((size_t)((SD_SIDX(t0) * 2 + SD_D(t0)) * 16 + SD_H(t0))) * 4096 + (SD_RG(t0) * 16 + rl) * 64 + 4 * ks);
            { float one_; asm volatile("v_mov_b32 %0, 1.0" : "=v"(one_)); S0 = S0 * one_; }
            f32x2 SaL = (f32x2){S0[0], S0[1]}, SbL = (f32x2){S0[2], S0[3]}, SaC = (f32x2){0.f, 0.f}, SbC = SaC;
            for (int it = -1; it <= 256; ++it) {
                const int tL = scan_desc(0, vb, it), tC = scan_desc(1, vb, it);
                if (SD_ACT(tL)) {
                    const LAS float* sbL = gL + (it & 1) * 6144; const LAS float* sbC = gC + (it & 1) * 6144;
                    const int vrowL = SD_RG(tL) * 16 + rl, vrowC = SD_RG(tC) * 16 + rl;
                    float yaccL = 0.f, qpL = 0.f;
                    if (SD_ACT(tC)) {
                        if (SD_CHUNK(tC) == 0) { SaC = (f32x2){0.f, 0.f}; SbC = SaC; }
                        float yaccC = 0.f, qpC = 0.f;
#pragma unroll
                        for (int s_ = 0; s_ < 16; ++s_) {
                            SCAN_LOADS(L, sbL, vrowL) SCAN_LOADS(C, sbC, vrowC)
                            ppL = dpp_add<0xB1>(ppL); ppC = dpp_add<0xB1>(ppC); qpL = dpp_add<0xB1>(qpL); qpC = dpp_add<0xB1>(qpC);
                            ppL = dpp_add<0x4E>(ppL); ppC = dpp_add<0x4E>(ppC); qpL = dpp_add<0x4E>(qpL); qpC = dpp_add<0x4E>(qpC);
                            ppL = dpp_add<0x141>(ppL); ppC = dpp_add<0x141>(ppC); qpL = dpp_add<0x141>(qpL); qpC = dpp_add<0x141>(qpC);
                            ppL = dpp_add<0x140>(ppL); ppC = dpp_add<0x140>(ppC); qpL = dpp_add<0x140>(qpL); qpC = dpp_add<0x140>(qpC);
                            SCAN_UPDATE(L) SCAN_UPDATE(C)
                        }
                        qpC = row16_sum(qpC); yaccC = (ks == 15) ? qpC : yaccC;
                        gC[12288 + (it & 1) * 256 + ks * 16 + rl] = yaccC;
                        if (SD_CHUNK(tC) == 15)
                            *(f32x4*)(p.out + (size_t)NTOK * D + ((size_t)((SD_SIDX(tC) * 2 + SD_D(tC)) * 16 + SD_H(tC))) * 4096 + vrowC * 64 + 4 * ks) = (f32x4){SaC[0], SaC[1], SbC[0], SbC[1]};
                    } else {
#pragma unroll
                        for (int s_ = 0; s_ < 16; ++s_) {
                            SCAN_LOADS(L, sbL, vrowL)
                            ppL = dpp_add<0xB1>(ppL); qpL = dpp_add<0xB1>(qpL); ppL = dpp_add<0x4E>(ppL); qpL = dpp_add<0x4E>(qpL);
                            ppL = dpp_add<0x141>(ppL); qpL = dpp_add<0x141>(qpL); ppL = dpp_add<0x140>(ppL); qpL = dpp_add<0x140>(qpL);
                            SCAN_UPDATE(L)
                        }
                    }
                    qpL = row16_sum(qpL); yaccL = (ks == 15) ? qpL : yaccL;
                    gL[12288 + (it & 1) * 256 + ks * 16 + rl] = yaccL;
                }
                __syncthreads();
            }
        }
    }
}

__device__ __forceinline__ void p9_post(const Frame& F, const Params& p) {
    const f16* Y = (const f16*)(p.ws + OFF_Y); const f16* V = (const f16*)(p.ws + OFF_V); const f16* G = (const f16*)((const unsigned char*)p.out + 24 * MiB);
    const float* BC = (const float*)(p.ws + OFF_BC); f16* YO = (f16*)(p.ws + OFF_R);
    const float* lg = inp(F, 21); const float* lb = inp(F, 22);
    for (int row = F.gw; row < NTOK; row += F.NGW) {
#pragma unroll 1
        for (int jj = 0; jj < 4; ++jj) {
            const int c = 4 * F.lane + 256 * jj; const size_t o = (size_t)row * D + c;
            f32x4 y = h4_to_f4(*(const h4*)(Y + o));
            const float mean = xor16_sum((y[0] + y[1]) + (y[2] + y[3])) * (1.0f / 64.0f);
            y = y - mean;
            const float var = xor16_sum((y[0] * y[0] + y[1] * y[1]) + (y[2] * y[2] + y[3] * y[3])) * (1.0f / 64.0f);
            const float rs = 1.0f / sqrtf(var + 64e-5f);
            const float bc = BC[row * 16 + 4 * jj + (F.lane >> 4)];
            const f32x4 v = h4_to_f4(*(const h4*)(V + o)), g = h4_to_f4(*(const h4*)(G + o));
            const f32x4 out = (y * rs * *(const f32x4*)(lg + c) + *(const f32x4*)(lb + c) + v * bc) * g;
            *(h4*)(YO + o) = f4_to_h4(out);
        }
    }
}

__global__ void __launch_bounds__(512, 2) mega_fwd(Params p) {
    extern __shared__ __attribute__((aligned(16))) unsigned char lds_raw[];
    cg::grid_group grid = cg::this_grid();
    Frame F; F.lds = (LAS unsigned char*)lds_raw; F.tid = threadIdx.x; F.lane = F.tid & 63; F.wave = __builtin_amdgcn_readfirstlane(F.tid >> 6);
    F.epoch = 0; F.G = gridDim.x; F.bid = blockIdx.x; F.gw = F.bid * 8 + F.wave; F.NGW = F.G * 8;
    if (F.tid == 0) {
#pragma unroll
        for (int i = 0; i < 28; ++i) *(LAS unsigned long long*)(F.lds + LDS_TAB + 8 * i) = (unsigned long long)p.in[i];
    }
    __syncthreads();
    unsigned char* ws = p.ws; const float* mod = (const float*)(ws + OFF_MOD);
    unsigned char* G8 = (unsigned char*)p.out; f16* Gg = (f16*)((unsigned char*)p.out + 24 * MiB);
#ifndef REP_G
#define REP_G 1
#endif
#ifndef REP_B
#define REP_B 1
#endif
#ifndef REP_S
#define REP_S 1
#endif
#ifndef REP_E
#define REP_E 0
#endif
#define IN(k) (p.ph_lo <= (k) && (k) < p.ph_hi)
#define SEAM(k) do { if (IN(k) && IN((k) + 1)) { for (int rb_ = 0; rb_ < REP_B; ++rb_) xcd_barrier(xbar, F.tid); } \
    { int l_; asm volatile("v_mbcnt_lo_u32_b32 %0, -1, 0\n\tv_mbcnt_hi_u32_b32 %0, -1, %0" : "=v"(l_)); F.lane = l_; F.tid = F.wave * 64 + l_; } } while (0)
    if (p.ph_hi == 0x7fffffff) grid.sync();
    if (F.tid == 0) { *(LAS unsigned*)(F.lds + LDS_XB) = 0u; *(LAS unsigned*)(F.lds + LDS_XB + 4) = 0u; }
    __syncthreads();
    XcdBarrier xbar = xcd_barrier_post((unsigned*)ws, (volatile LAS unsigned*)(F.lds + LDS_XB), F.tid);
    { int l_; asm volatile("v_mbcnt_lo_u32_b32 %0, -1, 0\n\tv_mbcnt_hi_u32_b32 %0, -1, %0" : "=v"(l_)); F.lane = l_; F.tid = F.wave * 64 + l_; }
    if (IN(0)) for (int rep_ = 0; rep_ < ((REP_E & 1) ? 2 : 1); ++rep_) { p0_prologue(F, p); __syncthreads(); }
    SEAM(0);
    if (IN(1)) for (int rep_ = 0; rep_ < ((REP_E & 2) ? 2 : 1); ++rep_) p1_h1(F, p);
    SEAM(1);
    if (IN(2)) { EpiSwiGLU E{(f16*)(ws + OFF_BIG)}; run_gemm(F, ws + OFF_H, ws + OFF_FFNIN, 2 * DFF, D, E); if (REP_G > 1) { run_gemm(F, ws + OFF_H, ws + OFF_FFNIN, 2 * DFF, D, E); } }
    SEAM(2);
    if (IN(3)) { EpiResid<0> E{inp(F, 0), inp(F, 1), nullptr, p.out, mod, 2, 0.5f}; run_gemm(F, ws + OFF_BIG, ws + OFF_FFNOUT, D, DFF, E); if (REP_G > 1) { run_gemm(F, ws + OFF_BIG, ws + OFF_FFNOUT, D, DFF, E); } }
    SEAM(3);
    if (IN(4)) for (int rep_ = 0; rep_ < ((REP_E & 4) ? 2 : 1); ++rep_) ln_phase<false, true, true>(F, p, 0, 3, 4);
    SEAM(4);
    if (IN(5)) { EpiMixProj E{(f16*)(ws + OFF_BIG), G8}; run_gemm(F, ws + OFF_H, ws + OFF_MIXW, NMIX, D, E); if (REP_G > 1) { run_gemm(F, ws + OFF_H, ws + OFF_MIXW, NMIX, D, E); } }
    SEAM(5);
    if (IN(6)) for (int rep_ = 0; rep_ < ((REP_E & 8) ? 2 : 1); ++rep_) p6_prep(F, p);
    SEAM(6);
    if (IN(7)) { EpiLora E{(f16*)(ws + OFF_W), (f16*)(ws + OFF_A), Gg, inp(F, 13), inp(F, 15)}; run_gemm(F, ws + OFF_LA, ws + OFF_LORA, LORA_N, LORA_K, E); if (REP_G > 1) { run_gemm(F, ws + OFF_LA, ws + OFF_LORA, LORA_N, LORA_K, E); } }
    SEAM(7);
    if (IN(8)) p8_scan(F, p);
#if REP_S > 1
    xcd_barrier(xbar, F.tid);
    { const int gt = F.bid * 512 + F.tid, NT = F.G * 512; f32x4* Y4 = (f32x4*)(p.ws + OFF_Y);
      for (int i = gt; i < NTOK * D * 2 / 16; i += NT) Y4[i] = (f32x4){0.f, 0.f, 0.f, 0.f}; }
    xcd_barrier(xbar, F.tid);
    p8_scan(F, p);
#endif
    SEAM(8);
    if (IN(9)) { for (int rep_ = 0; rep_ < ((REP_E & 16) ? 2 : 1); ++rep_) p9_post(F, p); __syncthreads(); EpiPool E{G8, (f16*)(ws + OFF_K)}; run_gemm(F, ws + OFF_PR, ws + OFF_PB, D, 512, E); }
    SEAM(9);
    if (IN(10)) { EpiMerge E{G8, (const f16*)(ws + OFF_K), (f16*)(ws + OFF_BIG)}; run_gemm(F, ws + OFF_R, ws + OFF_ORWKV, D, D, E); if (REP_G > 1) { run_gemm(F, ws + OFF_R, ws + OFF_ORWKV, D, D, E); } }
    SEAM(10);
    if (IN(11)) { EpiResid<1> E{nullptr, nullptr, (const f16*)(ws + OFF_X1H), p.out, mod, 5, 1.0f}; run_gemm(F, ws + OFF_BIG, ws + OFF_OUTW, D, D, E); if (REP_G > 1) { run_gemm(F, ws + OFF_BIG, ws + OFF_OUTW, D, D, E); } }
    SEAM(11);
    if (IN(12)) { ln_phase<true, false, true>(F, p, 1, 6, 7); __syncthreads(); convert_ffn(F, p, 1); }
    SEAM(12);
    if (IN(13)) { EpiSwiGLU E{(f16*)(ws + OFF_BIG)}; run_gemm(F, ws + OFF_H, ws + OFF_FFNIN, 2 * DFF, D, E); if (REP_G > 1) { run_gemm(F, ws + OFF_H, ws + OFF_FFNIN, 2 * DFF, D, E); } }
    SEAM(13);
    if (IN(14)) { EpiResid<2> E{nullptr, nullptr, nullptr, p.out, mod, 8, 0.5f}; run_gemm(F, ws + OFF_BIG, ws + OFF_FFNOUT, D, DFF, E); }
    SEAM(14);
    if (IN(15)) ln_phase<true, false, false>(F, p, 2, 0, 0);
}

extern "C" void kernel_launch(void* const* d_in, const int* in_sizes, int n_in, void* d_out, int out_size, void* d_ws, size_t ws_size, hipStream_t stream) {
    static int grid = 0;
    if (grid == 0) {
        if (n_in != 28 || ws_size < WS_END) { fprintf(stderr, "kernel_launch: need 28 inputs and %zu bytes of workspace (got %d, %zu)\n", (size_t)WS_END, n_in, ws_size); grid = -1; return; }
        int dev = 0, cus = 0, per_cu = 0;
        hipGetDevice(&dev); hipDeviceGetAttribute(&cus, hipDeviceAttributeMultiprocessorCount, dev);
        if (hipFuncSetAttribute((const void*)mega_fwd, hipFuncAttributeMaxDynamicSharedMemorySize, LDS_BYTES) != hipSuccess) { fprintf(stderr, "kernel_launch: hipFuncSetAttribute failed\n"); grid = -1; return; }
        if (hipOccupancyMaxActiveBlocksPerMultiprocessor(&per_cu, (const void*)mega_fwd, 512, LDS_BYTES) != hipSuccess || per_cu < 1) { fprintf(stderr, "kernel_launch: occupancy query says %d\n", per_cu); grid = -1; return; }
        grid = cus * per_cu; if (grid > 256) grid = 256;
        fprintf(stderr, "kernel_launch: grid %d (cus %d x %d)\n", grid, cus, per_cu);
    }
    if (grid < 0) return;
    Params p{};
    for (int i = 0; i < 28; ++i) p.in[i] = (const float*)d_in[i];
    p.out = (float*)d_out; p.ws = (unsigned char*)d_ws;
#if MK_MULTI
    for (int ph = 0; ph < 16; ++ph) { p.ph_lo = ph; p.ph_hi = ph + 1; hipLaunchKernelGGL(mega_fwd, dim3(grid), dim3(512), LDS_BYTES, stream, p); }
#else
    p.ph_lo = 0; p.ph_hi = 16;
    if (hipMemsetAsync(d_ws, 0, 16384, stream) != hipSuccess) { fprintf(stderr, "kernel_launch: memset failed\n"); return; }
    void* args[] = {&p};
    hipError_t e = hipLaunchCooperativeKernel((const void*)mega_fwd, dim3(grid), dim3(512), args, LDS_BYTES, stream);
    if (e != hipSuccess) fprintf(stderr, "kernel_launch: cooperative launch failed: %s (grid %d)\n", hipGetErrorString(e), grid);
#endif
}
```
